# Optimizing an MI355X kernel written in HIP

```python
import math
import jax, jax.numpy as jnp
from jax import lax
import numpy as np

D_MODEL = 2048
BATCH = 4
SEQ = 4096
DEPTH = 2

LRU_WIDTH = D_MODEL
LRU_HEADS = 16
LRU_HEAD_DIM = LRU_WIDTH // LRU_HEADS
CONV_W = 4
LRU_C = 8.0
HEAD_DIM = 128
N_Q_HEADS = 16
N_KV_HEADS = 4
GQA_GROUP = N_Q_HEADS // N_KV_HEADS
WINDOW = 128
ATTN_WIDTH = N_Q_HEADS * HEAD_DIM
KV_WIDTH = N_KV_HEADS * HEAD_DIM
N_BRANCHES = 2
C_IN = 2 * LRU_WIDTH + ATTN_WIDTH + 2 * KV_WIDTH + N_BRANCHES * D_MODEL
SPLITS = tuple(np.cumsum([LRU_WIDTH, LRU_WIDTH, ATTN_WIDTH, KV_WIDTH, KV_WIDTH]).tolist())
FFN_HIDDEN = int(math.ceil(8 * D_MODEL / 3 / 256) * 256)
N_MOD = 6
EPS = 1e-6

kernel_name = "hybrid_rglru_swa_sink_adaln_block"


def rms_norm(x, g):
    xf = x.astype(jnp.float32)
    inv = lax.rsqrt(jnp.mean(xf * xf, axis=-1, keepdims=True) + EPS)
    return (xf * inv).astype(x.dtype) * g


def modulate(h, shift, scale):
    return h * (1 + scale) + shift


def causal_depthwise_conv(u, w, b):
    S = u.shape[1]
    up = jnp.pad(u, ((0, 0), (CONV_W - 1, 0), (0, 0)))
    out = b
    for k in range(CONV_W):
        out = out + up[:, k:k + S, :] * w[k]
    return out


def rg_lru(u, wa, ba, wx, bx, lam):
    B, S, C = u.shape
    uh = u.reshape(B, S, LRU_HEADS, LRU_HEAD_DIM)
    r = jax.nn.sigmoid(jnp.einsum('bshi,hij->bshj', uh, wa).reshape(B, S, C) + ba)
    i = jax.nn.sigmoid(jnp.einsum('bshi,hij->bshj', uh, wx).reshape(B, S, C) + bx)
    log_a = -LRU_C * r.astype(jnp.float32) * jax.nn.softplus(-lam.astype(jnp.float32))
    a = jnp.exp(log_a)
    beta = jnp.sqrt(-jnp.expm1(2.0 * log_a))
    inp = beta * (i * u).astype(jnp.float32)

    def combine(left, right):
        a1, b1 = left
        a2, b2 = right
        return a1 * a2, a2 * b1 + b2

    _, h = lax.associative_scan(combine, (a, inp), axis=1)
    return h.astype(u.dtype)


def sliding_window_attention(q, k, v, sinks):
    B, S = q.shape[0], q.shape[1]
    nb = S // WINDOW
    qb = q.reshape(B, nb, WINDOW, N_KV_HEADS, GQA_GROUP, HEAD_DIM)
    kb = k.reshape(B, nb, WINDOW, N_KV_HEADS, HEAD_DIM)
    vb = v.reshape(B, nb, WINDOW, N_KV_HEADS, HEAD_DIM)
    pad = ((0, 0), (1, 0), (0, 0), (0, 0), (0, 0))
    kw = jnp.concatenate([jnp.pad(kb, pad)[:, :-1], kb], axis=2)
    vw = jnp.concatenate([jnp.pad(vb, pad)[:, :-1], vb], axis=2)
    s = jnp.einsum('bnqhgd,bnkhd->bnhgqk', qb, kw).astype(jnp.float32) * (HEAD_DIM ** -0.5)
    qi = jnp.arange(WINDOW)[:, None]
    kk = jnp.arange(2 * WINDOW)[None, :]
    band = (kk > qi) & (kk <= qi + WINDOW)
    blk = jnp.arange(nb)[:, None, None]
    valid = band[None] & (blk * WINDOW + kk[None] - WINDOW >= 0)
    s = jnp.where(valid[None, :, None, None], s, -jnp.inf)
    sink = sinks.astype(jnp.float32).reshape(N_KV_HEADS, GQA_GROUP)[None, None, :, :, None, None]
    m = jnp.maximum(jnp.max(s, axis=-1, keepdims=True), sink)
    p = jnp.exp(s - m)
    denom = jnp.sum(p, axis=-1, keepdims=True) + jnp.exp(sink - m)
    p = (p / denom).astype(v.dtype)
    o = jnp.einsum('bnhgqk,bnkhd->bnqhgd', p, vw)
    return o.reshape(B, S, ATTN_WIDTH)


def setup_inputs(seed: int = 0) -> dict:
    key = jax.random.key(seed)
    ks = jax.random.split(key, 24)
    f32 = jnp.float32

    def nrm(k, shape, scale):
        return jax.random.normal(k, shape, f32) * scale

    a0 = jax.random.uniform(ks[11], (DEPTH, LRU_WIDTH), f32, 0.9, 0.999)
    p0 = a0 ** (1.0 / LRU_C)
    lru_lambda = jnp.log(p0) - jnp.log1p(-p0)
    return {
        "x": nrm(ks[0], (BATCH, SEQ, D_MODEL), 1.0),
        "c": nrm(ks[1], (BATCH, D_MODEL), 1.0),
        "ada_w": nrm(ks[2], (DEPTH, D_MODEL, N_MOD * D_MODEL), D_MODEL ** -0.5),
        "ada_b": nrm(ks[3], (DEPTH, N_MOD * D_MODEL), 0.01),
        "norm1_g": 1.0 + nrm(ks[4], (DEPTH, D_MODEL), 0.02),
        "w_in": nrm(ks[5], (DEPTH, D_MODEL, C_IN), D_MODEL ** -0.5),
        "b_in": nrm(ks[6], (DEPTH, C_IN), 0.01),
        "conv_w": nrm(ks[7], (DEPTH, CONV_W, LRU_WIDTH), CONV_W ** -0.5),
        "conv_b": nrm(ks[8], (DEPTH, LRU_WIDTH), 0.01),
        "lru_wa": nrm(ks[9], (DEPTH, LRU_HEADS, LRU_HEAD_DIM, LRU_HEAD_DIM), LRU_HEAD_DIM ** -0.5),
        "lru_ba": nrm(ks[10], (DEPTH, LRU_WIDTH), 0.01),
        "lru_wx": nrm(ks[12], (DEPTH, LRU_HEADS, LRU_HEAD_DIM, LRU_HEAD_DIM), LRU_HEAD_DIM ** -0.5),
        "lru_bx": nrm(ks[13], (DEPTH, LRU_WIDTH), 0.01),
        "lru_lambda": lru_lambda,
        "sinks": nrm(ks[14], (DEPTH, N_Q_HEADS), 0.5),
        "w_lru_out": nrm(ks[15], (DEPTH, LRU_WIDTH, D_MODEL), LRU_WIDTH ** -0.5),
        "w_attn_out": nrm(ks[16], (DEPTH, ATTN_WIDTH, D_MODEL), ATTN_WIDTH ** -0.5),
        "w_o": nrm(ks[17], (DEPTH, D_MODEL, D_MODEL), D_MODEL ** -0.5),
        "norm2_g": 1.0 + nrm(ks[18], (DEPTH, D_MODEL), 0.02),
        "w_ffn_in": nrm(ks[19], (DEPTH, D_MODEL, 2 * FFN_HIDDEN), D_MODEL ** -0.5),
        "w_ffn_out": nrm(ks[20], (DEPTH, FFN_HIDDEN, D_MODEL), FFN_HIDDEN ** -0.5),
        "final_g": 1.0 + nrm(ks[21], (D_MODEL,), 0.02),
    }


def reference(x, c, ada_w, ada_b, norm1_g, w_in, b_in, conv_w, conv_b, lru_wa, lru_ba,
              lru_wx, lru_bx, lru_lambda, sinks, w_lru_out, w_attn_out, w_o, norm2_g,
              w_ffn_in, w_ffn_out, final_g):
    B, S, _ = x.shape
    c_act = jax.nn.silu(c)
    for l in range(DEPTH):
        mod = (c_act @ ada_w[l] + ada_b[l])[:, None, :]
        sh1, sc1, g1, sh2, sc2, g2 = jnp.split(mod, N_MOD, axis=-1)

        h = modulate(rms_norm(x, norm1_g[l]), sh1, sc1)
        proj = h @ w_in[l] + b_in[l]
        u, lru_gate, q, k, v, mix_gates = jnp.split(proj, SPLITS, axis=-1)

        u = causal_depthwise_conv(u, conv_w[l], conv_b[l])
        y_lru = rg_lru(u, lru_wa[l], lru_ba[l], lru_wx[l], lru_bx[l], lru_lambda[l])
        y_lru = y_lru * jax.nn.gelu(lru_gate, approximate=True)

        y_attn = sliding_window_attention(
            q.reshape(B, S, N_Q_HEADS, HEAD_DIM),
            k.reshape(B, S, N_KV_HEADS, HEAD_DIM),
            v.reshape(B, S, N_KV_HEADS, HEAD_DIM),
            sinks[l])

        gate_lru, gate_attn = jnp.split(jax.nn.sigmoid(mix_gates), N_BRANCHES, axis=-1)
        merged = gate_lru * (y_lru @ w_lru_out[l]) + gate_attn * (y_attn @ w_attn_out[l])
        x = x + g1 * (merged @ w_o[l])

        h2 = modulate(rms_norm(x, norm2_g[l]), sh2, sc2)
        gate, up = jnp.split(h2 @ w_ffn_in[l], 2, axis=-1)
        x = x + g2 * ((jax.nn.silu(gate) * up) @ w_ffn_out[l])
    return rms_norm(x, final_g)
```

```cpp
#include <hip/hip_runtime.h>
#include <hip/hip_cooperative_groups.h>
#include <cstdio>
#include <cstdint>
namespace cg = cooperative_groups;
namespace pg8 {
#define PG8_LAS __attribute__((address_space(3)))
typedef unsigned short bf16_t;
typedef short bf16x8 __attribute__((ext_vector_type(8)));
typedef float f32x4 __attribute__((ext_vector_type(4)));
typedef unsigned u32x4 __attribute__((ext_vector_type(4)));
constexpr int BM = 256, BK = 64, HALF = 128, HTB = HALF * BK * 2  , STAGE_BYTES = 8 * HTB, NXCD = 8, WGM = 8;

__host__ __device__ __forceinline__ int lds_byte(int r, int c) { const int st = (r >> 4) * 2 + (c >> 5), rr = r & 15, cc = c & 31, ob = rr * 64 + cc * 2; return st * 1024 + (ob ^ (((ob >> 9) & 1) << 5)); }
__host__ __device__ __forceinline__ void stage_rc(int b, int& R, int& C) { const int st = b / 1024, sb = b % 1024, swz = sb ^ (((sb >> 9) & 1) << 5); R = (st >> 1) * 16 + swz / 64; C = (st & 1) * 32 + (swz % 64) / 2; }
__host__ __device__ __forceinline__ int perm32(int rho) { const int n = rho >> 4, i = rho & 15; return 8 * (i >> 2) + 4 * n + (i & 3); }

struct Unit { int pm, pn; };
struct Gemm { const bf16_t* A; const bf16_t* Bt; int M, N, K; const bf16_t* A2 = nullptr; const bf16_t* Bt2 = nullptr; };

struct StaticOrder {
    int nM, nN, nwg, G, c;
    __host__ __device__ void init(int M, int N, int G_, int c_) { nM = M / BM; nN = N / BM; nwg = nM * nN; G = G_; c = c_; }
    __host__ __device__ bool next(int i, Unit& u) const {
        const long L = (long)i * G + c; if (L >= nwg) return false;
        int wgid = (int)L; { const int q = nwg / NXCD, r = nwg % NXCD, xcd = wgid % NXCD, off = wgid / NXCD; wgid = (xcd < r ? xcd * (q + 1) : r * (q + 1) + (xcd - r) * q) + off; }
        const int nig = WGM * nN, gid = wgid / nig, fm = gid * WGM, gsz = (nM - fm) < WGM ? (nM - fm) : WGM;
        u.pm = fm + ((wgid % nig) % gsz); u.pn = (wgid % nig) / gsz; return true;
    }
    __device__ __forceinline__ void a_ready(const Unit&) const {}
    __device__ __forceinline__ void done(const Unit&) const {}
};
__device__ __forceinline__ unsigned cvt_pk_bf16(float lo, float hi) { unsigned r; asm volatile("v_cvt_pk_bf16_f32 %0, %1, %2" : "=v"(r) : "v"(lo), "v"(hi)); return r; }
typedef float f32x2 __attribute__((ext_vector_type(2)));
template <class Epi, class Sched, bool ALIGN_EPI = false, bool SP2 = false>
__device__ __forceinline__ void gemm_phase(PG8_LAS unsigned char* lds, const Gemm g, const Sched& S, const Epi& E) {
    int tid_ = threadIdx.x; asm volatile("" : "+v"(tid_));
    const int tid = tid_, wid = __builtin_amdgcn_readfirstlane(tid >> 6), lane = tid & 63, wr = wid >> 2, wc = wid & 3, fr = lane & 15, fq = lane >> 4;
    const int K = g.K, nt1 = K / BK, nt = Epi::DUAL ? 2 * nt1 : nt1;
    unsigned voffA[2], voffB[2];
#pragma unroll
    for (int i = 0; i < 2; ++i) { int R, C; stage_rc(tid * 16 + i * 8192, R, C); const int Rb = Epi::PERM ? ((R & ~31) + perm32(R & 31)) : R;
        voffA[i] = (unsigned)(R * K + C) * 2u; voffB[i] = (unsigned)(Rb * K + C) * 2u; }
    const size_t kstep = (size_t)(BK * 2);
    const size_t hstep = (size_t)HALF * K * 2;
    const size_t tstep = 2 * hstep;
    const unsigned ldsw = (unsigned)wid * 1024u;
    const int aoff = lds_byte(wr * 64 + fr, fq * 8), boff = lds_byte(wc * 32 + fr, fq * 8);
#define PG8_SA(b, h) (((b) * 2 + (h)) * HTB)
#define PG8_SB(b, h) ((4 + (b) * 2 + (h)) * HTB)
#define PG8_STAGE(bufoff, gbase, voff) do { _Pragma("unroll") for (int _i = 0; _i < 2; ++_i) \
        __builtin_amdgcn_global_load_lds((const unsigned*)((const char*)(gbase) + (voff)[_i]), (PG8_LAS unsigned*)(lds + (bufoff) + ldsw + _i * 8192), 16, 0, 0); } while (0)
#define PG8_LDA(dst, b, h) do { _Pragma("unroll") for (int m = 0; m < 4; ++m) _Pragma("unroll") for (int k = 0; k < 2; ++k) dst[m][k] = *(const PG8_LAS bf16x8*)(lds + PG8_SA(b, h) + aoff + m * 2048 + k * 1024); } while (0)
#define PG8_LDB(dst, b, h) do { _Pragma("unroll") for (int n = 0; n < 2; ++n) _Pragma("unroll") for (int k = 0; k < 2; ++k) dst[n][k] = *(const PG8_LAS bf16x8*)(lds + PG8_SB(b, h) + boff + n * 2048 + k * 1024); } while (0)
#define PG8_MMA(ai, bj, At, Bt) do { __builtin_amdgcn_s_setprio(1); _Pragma("unroll") for (int m = 0; m < 4; ++m) _Pragma("unroll") for (int n = 0; n < 2; ++n) _Pragma("unroll") for (int k = 0; k < 2; ++k) \
        acc[ai][bj][m][n] = __builtin_amdgcn_mfma_f32_16x16x32_bf16(Bt[n][k], At[m][k], acc[ai][bj][m][n], 0, 0, 0); __builtin_amdgcn_s_setprio(0); } while (0)
#define PG8_WAIT_V(n) asm volatile("s_waitcnt vmcnt(" #n ")" ::: "memory")
#define PG8_WAIT_L(n) asm volatile("s_waitcnt lgkmcnt(" #n ")" ::: "memory")
#define PG8_BAR __builtin_amdgcn_s_barrier()
#define PG8_SCHED __builtin_amdgcn_sched_barrier(0)
    Unit cur, nxt; int ui = 0;
    if (!S.next(0, cur)) return;
    f32x4 acc[2][2][4][2];
#pragma unroll
    for (int a = 0; a < 2; ++a)
#pragma unroll
        for (int b = 0; b < 2; ++b)
#pragma unroll
            for (int m = 0; m < 4; ++m)
#pragma unroll
                for (int n = 0; n < 2; ++n) acc[a][b][m][n] = (f32x4){0.f, 0.f, 0.f, 0.f};
    bf16x8 At[4][2], B0[2][2], B1[2][2];
    const char* cA = (const char*)g.A + (size_t)cur.pm * tstep; const char* cB = (const char*)g.Bt + (size_t)cur.pn * tstep;
    const char* cA2 = Epi::DUAL ? (const char*)g.A2 + (size_t)cur.pm * tstep : cA; const char* cB2 = Epi::DUAL ? (const char*)g.Bt2 + (size_t)cur.pn * tstep : cB;
    S.a_ready(cur);
    if constexpr (SP2) {
        PG8_STAGE(PG8_SB(0, 0), cB, voffB); PG8_STAGE(PG8_SB(0, 1), cB + hstep, voffB); PG8_STAGE(PG8_SA(0, 0), cA, voffA); PG8_STAGE(PG8_SA(0, 1), cA + hstep, voffA);
        if (wr == 1) PG8_BAR;
        PG8_WAIT_V(2); PG8_BAR;
        PG8_STAGE(PG8_SB(1, 0), cB + kstep, voffB); PG8_STAGE(PG8_SA(1, 0), cA + kstep, voffA); PG8_STAGE(PG8_SB(1, 1), cB + hstep + kstep, voffB);
        PG8_WAIT_V(6); PG8_BAR;
    } else {
        PG8_STAGE(PG8_SB(0, 0), cB, voffB); PG8_STAGE(PG8_SA(0, 0), cA, voffA); PG8_STAGE(PG8_SB(0, 1), cB + hstep, voffB); PG8_STAGE(PG8_SA(0, 1), cA + hstep, voffA);
        if (wr == 1) PG8_BAR;
        PG8_WAIT_V(4); PG8_BAR;
        PG8_STAGE(PG8_SB(1, 0), cB + kstep, voffB); PG8_STAGE(PG8_SA(1, 0), cA + kstep, voffA); PG8_STAGE(PG8_SB(1, 1), cB + hstep + kstep, voffB);
        PG8_WAIT_V(6); PG8_BAR;
    }
    for (;;) {
        const bool has_next = S.next(ui + 1, nxt);
        const char* nA = has_next ? (const char*)g.A + (size_t)nxt.pm * tstep : cA; const char* nB = has_next ? (const char*)g.Bt + (size_t)nxt.pn * tstep : cB;
        for (int t = 0; t < nt; t += 2) {
            const bool last = (t == nt - 2);
            const char* tA1 = cA + (size_t)(t + 1) * kstep; const char* tA2 = cA + (size_t)(t + 2) * kstep; const char* tB2 = cB + (size_t)(t + 2) * kstep;
            if constexpr (Epi::DUAL) {
                if (t >= nt1) tA1 = cA2 + (size_t)(t + 1 - nt1) * kstep;
                if (t + 2 >= nt1) { tA2 = cA2 + (size_t)(t + 2 - nt1) * kstep; tB2 = cB2 + (size_t)(t + 2 - nt1) * kstep; }
                if (t == nt1) { int fr_m = fr, fq_m = fq; asm volatile("" : "+v"(fr_m), "+v"(fq_m)); E.mid(acc, cur, wr, wc, fr_m, fq_m); }
            }
            const char* a1 = tA1;
            const char* a2 = last ? nA : tA2; const char* b2 = last ? nB : tB2;
            const char* a3 = a2 + kstep; const char* b3 = b2 + kstep;
            if (last && has_next) S.a_ready(nxt);
            if constexpr (SP2) {
            PG8_LDB(B0, 0, 0); PG8_LDB(B1, 0, 1); PG8_SCHED; PG8_LDA(At, 0, 0); PG8_STAGE(PG8_SA(1, 1), a1 + hstep, voffA);
            PG8_WAIT_V(8); PG8_WAIT_L(0); PG8_BAR; PG8_MMA(0, 0, At, B0); PG8_MMA(0, 1, At, B1); PG8_BAR; PG8_SCHED;
            PG8_LDA(At, 0, 1); PG8_STAGE(PG8_SB(0, 0), b2, voffB); PG8_STAGE(PG8_SB(0, 1), b2 + hstep, voffB); PG8_STAGE(PG8_SA(0, 0), a2, voffA);
            PG8_WAIT_V(8); PG8_WAIT_L(0); PG8_BAR; PG8_MMA(1, 0, At, B0); PG8_MMA(1, 1, At, B1); PG8_BAR; PG8_SCHED;
            PG8_LDB(B0, 1, 0); PG8_LDB(B1, 1, 1); PG8_SCHED; PG8_LDA(At, 1, 0); PG8_STAGE(PG8_SA(0, 1), a2 + hstep, voffA);
            PG8_WAIT_V(8); PG8_WAIT_L(0); PG8_BAR; PG8_MMA(0, 0, At, B0); PG8_MMA(0, 1, At, B1); PG8_BAR; PG8_SCHED;
            PG8_LDA(At, 1, 1); PG8_STAGE(PG8_SB(1, 0), b3, voffB); PG8_STAGE(PG8_SB(1, 1), b3 + hstep, voffB); PG8_STAGE(PG8_SA(1, 0), a3, voffA);
            PG8_WAIT_V(8); PG8_WAIT_L(0); PG8_BAR; PG8_MMA(1, 0, At, B0); PG8_MMA(1, 1, At, B1); PG8_BAR; PG8_SCHED;
            } else {
            PG8_LDB(B0, 0, 0); PG8_SCHED; PG8_LDA(At, 0, 0); PG8_STAGE(PG8_SA(1, 1), a1 + hstep, voffA);
            PG8_WAIT_L(8); PG8_BAR; PG8_WAIT_L(0); PG8_MMA(0, 0, At, B0); PG8_BAR; PG8_SCHED;
            PG8_LDB(B1, 0, 1); PG8_STAGE(PG8_SB(0, 0), b2, voffB);
            PG8_BAR; PG8_WAIT_L(0); PG8_MMA(0, 1, At, B1); PG8_BAR;
            PG8_LDA(At, 0, 1); PG8_STAGE(PG8_SA(0, 0), a2, voffA);
            PG8_BAR; PG8_WAIT_L(0); PG8_MMA(1, 0, At, B0); PG8_BAR; PG8_SCHED;
            PG8_STAGE(PG8_SB(0, 1), b2 + hstep, voffB);
            PG8_WAIT_V(6); PG8_BAR; PG8_MMA(1, 1, At, B1); PG8_BAR;
            PG8_LDB(B0, 1, 0); PG8_SCHED; PG8_LDA(At, 1, 0); PG8_STAGE(PG8_SA(0, 1), a2 + hstep, voffA);
            PG8_WAIT_L(8); PG8_BAR; PG8_WAIT_L(0); PG8_MMA(0, 0, At, B0); PG8_BAR; PG8_SCHED;
            PG8_LDB(B1, 1, 1); PG8_STAGE(PG8_SB(1, 0), b3, voffB);
            PG8_BAR; PG8_WAIT_L(0); PG8_MMA(0, 1, At, B1); PG8_BAR;
            PG8_LDA(At, 1, 1); PG8_STAGE(PG8_SA(1, 0), a3, voffA);
            PG8_BAR; PG8_WAIT_L(0); PG8_MMA(1, 0, At, B0); PG8_BAR; PG8_SCHED;
            PG8_STAGE(PG8_SB(1, 1), b3 + hstep, voffB);
            PG8_WAIT_V(6); PG8_BAR; PG8_MMA(1, 1, At, B1); PG8_BAR;
            }
        }
        if constexpr (ALIGN_EPI) { if (wr == 0) PG8_BAR; }
        if constexpr (!Epi::AFTER_DRAIN) { int fr_e = fr, fq_e = fq; asm volatile("" : "+v"(fr_e), "+v"(fq_e)); E(acc, cur, wr, wc, fr_e, fq_e); S.done(cur); }
        if (!has_next) break;
#pragma unroll
        for (int a = 0; a < 2; ++a)
#pragma unroll
            for (int b = 0; b < 2; ++b)
#pragma unroll
                for (int m = 0; m < 4; ++m)
#pragma unroll
                    for (int n = 0; n < 2; ++n) acc[a][b][m][n] = (f32x4){0.f, 0.f, 0.f, 0.f};
        cur = nxt; cA = nA; cB = nB; ++ui;
        if constexpr (Epi::DUAL) { cA2 = (const char*)g.A2 + (size_t)cur.pm * tstep; cB2 = (const char*)g.Bt2 + (size_t)cur.pn * tstep; }
        if constexpr (ALIGN_EPI) { if (wr == 1) PG8_BAR; }
    }
    PG8_WAIT_V(0);
    if constexpr (!ALIGN_EPI) { if (wr == 0) PG8_BAR; }
    PG8_BAR;
    if constexpr (Epi::AFTER_DRAIN) { E.fused(acc, cur, wr, wc, fr, fq, lds, wid, lane); S.done(cur); }
#undef PG8_SA
#undef PG8_SB
#undef PG8_STAGE
#undef PG8_LDA
#undef PG8_LDB
#undef PG8_MMA
#undef PG8_WAIT_V
#undef PG8_WAIT_L
#undef PG8_BAR
#undef PG8_SCHED
}
}

constexpr int NWAVES = 8;
constexpr int D = 2048, SEQ = 4096, NB = 4, M = NB * SEQ, CIN = 11264, FFN = 5632, NMOD = 6, DEPTH = 2;
constexpr float EPS = 1e-6f, LOG2E = 1.4426950408889634f;
constexpr float SC2 = 0.08838834764831845f * 1.4426950408889634f;

constexpr size_t MiB = 1u << 20;
constexpr size_t WS_BAR = 0, BAR_ZERO_BYTES = 16384;
constexpr size_t WS_MODP = 2 * MiB;
constexpr size_t WS_MOD = 9 * MiB;
constexpr size_t WS_W = 16 * MiB, W_LAYER = 135 * MiB;
constexpr size_t WO_IN = 0, WO_LO = 44 * MiB, WO_AO = 52 * MiB, WO_O = 60 * MiB, WO_FI = 68 * MiB, WO_FO = 112 * MiB, WO_WA = 134 * MiB, WO_WX = 134 * MiB + 512 * 1024;
constexpr size_t WS_H = 288 * MiB;
constexpr size_t WS_U = 352 * MiB, WS_LG = 416 * MiB, WS_Q = 480 * MiB, WS_K = 544 * MiB, WS_VT = 560 * MiB, WS_MG = 576 * MiB;
constexpr size_t WS_HID = 352 * MiB;
constexpr size_t WS_XB = 704 * MiB;
constexpr size_t WS_END = 768 * MiB;
constexpr int LDS_BYTES = 155648;

#define GAS __attribute__((address_space(1)))
#define LAS __attribute__((address_space(3)))
typedef unsigned short bf16;
typedef unsigned v4u __attribute__((ext_vector_type(4)));
typedef unsigned v2u __attribute__((ext_vector_type(2)));
typedef float f32x4 __attribute__((ext_vector_type(4)));
typedef float f32x16 __attribute__((ext_vector_type(16)));
typedef short bf16x8 __attribute__((ext_vector_type(8)));
typedef short s16x4 __attribute__((ext_vector_type(4)));
typedef short v4i16_t __attribute__((ext_vector_type(4)));
typedef __bf16 bf16x2_t __attribute__((ext_vector_type(2)));
typedef float f32x2_t __attribute__((ext_vector_type(2)));
#define LDS_WAIT() asm volatile("s_waitcnt lgkmcnt(0)" ::: "memory")

__device__ __forceinline__ unsigned pk2(float lo, float hi) { f32x2_t v = {lo, hi}; bf16x2_t b = __builtin_convertvector(v, bf16x2_t); return __builtin_bit_cast(unsigned, b); }
__device__ __forceinline__ float bflo(unsigned w) { return __builtin_bit_cast(float, w << 16); }
__device__ __forceinline__ float bfhi(unsigned w) { return __builtin_bit_cast(float, w & 0xffff0000u); }
__device__ __forceinline__ float bf2f(bf16 b) { return __builtin_bit_cast(float, ((unsigned)b) << 16); }
__device__ __forceinline__ float sigmoid_f(float v) { return __builtin_amdgcn_rcpf(1.0f + __builtin_amdgcn_exp2f(-v * LOG2E)); }
__device__ __forceinline__ float gelu_tanh_f(float v) { const float z = 1.5957691216057308f * (v + 0.044715f * v * v * v); return v * sigmoid_f(z); }
__device__ __forceinline__ float wave_sum(float v) {
#pragma unroll
    for (int o = 1; o < 64; o <<= 1) v += __shfl_xor(v, o);
    return v;
}

using pg8::Unit; using pg8::bf16_t;
struct EpiIn {
    static constexpr bool PERM = true, AFTER_DRAIN = false, DUAL = false;
    const float* bias; bf16* U; bf16* LG; bf16* Q; bf16* Kb; bf16* Vt; bf16* MG;
    template <int MODE> __device__ __forceinline__ void body(const f32x4 (&acc)[2][2][4][2], bf16* base, int ldc, int c0, int row0, int lc, const f32x4 (&bv)[2][2]) const {
#pragma unroll
        for (int ai = 0; ai < 2; ++ai)
#pragma unroll
            for (int m = 0; m < 4; ++m) {
                const int row = row0 + ai * 128 + m * 16;
#pragma unroll
                for (int bj = 0; bj < 2; ++bj) {
                    f32x4 v0 = acc[ai][bj][m][0] + bv[bj][0], v1 = acc[ai][bj][m][1] + bv[bj][1];
                    if (MODE == 1) {
#pragma unroll
                        for (int j = 0; j < 4; ++j) { v0[j] = gelu_tanh_f(v0[j]); v1[j] = gelu_tanh_f(v1[j]); }
                    } else if (MODE == 2) {
#pragma unroll
                        for (int j = 0; j < 4; ++j) { v0[j] = sigmoid_f(v0[j]); v1[j] = sigmoid_f(v1[j]); }
                    }
                    v4u w; w.x = pk2(v0[0], v0[1]); w.y = pk2(v0[2], v0[3]); w.z = pk2(v1[0], v1[1]); w.w = pk2(v1[2], v1[3]);
                    if (MODE != 3) {
                        *(v4u*)(base + (size_t)row * ldc + c0 + bj * 128 + lc) = w;
                    } else {
                        const int b = row >> 12, s = row & 4095, cv = c0 + bj * 128 + lc;
                        bf16* p = base + (((size_t)(b * 512 + cv)) << 12) + s;
                        p[0 << 12] = (bf16)(w.x & 0xffffu); p[1 << 12] = (bf16)(w.x >> 16);
                        p[2 << 12] = (bf16)(w.y & 0xffffu); p[3 << 12] = (bf16)(w.y >> 16);
                        p[4 << 12] = (bf16)(w.z & 0xffffu); p[5 << 12] = (bf16)(w.z >> 16);
                        p[6 << 12] = (bf16)(w.w & 0xffffu); p[7 << 12] = (bf16)(w.w >> 16);
                    }
                }
            }
    }
    __device__ __forceinline__ void body_mix(const f32x4 (&acc)[2][2][4][2], int t, int row0, int lc, const f32x4 (&bv)[2][2]) const {
#pragma unroll
        for (int ai = 0; ai < 2; ++ai)
#pragma unroll
            for (int m = 0; m < 4; ++m) {
                const int row = row0 + ai * 128 + m * 16;
                float rt[8], sb[8];
#pragma unroll
                for (int n = 0; n < 2; ++n)
#pragma unroll
                    for (int j = 0; j < 4; ++j) {
                        const float a = acc[ai][0][m][n][j] + bv[0][n][j], b = acc[ai][1][m][n][j] + bv[1][n][j];
                        const float ea = __builtin_amdgcn_exp2f(-a * LOG2E), eb = __builtin_amdgcn_exp2f(-b * LOG2E);
                        sb[4 * n + j] = __builtin_amdgcn_rcpf(1.0f + eb);
                        rt[4 * n + j] = (1.0f + eb) * __builtin_amdgcn_rcpf(1.0f + ea);
                    }
                v4u w0, w1;
                w0.x = pk2(rt[0], rt[1]); w0.y = pk2(rt[2], rt[3]); w0.z = pk2(rt[4], rt[5]); w0.w = pk2(rt[6], rt[7]);
                w1.x = pk2(sb[0], sb[1]); w1.y = pk2(sb[2], sb[3]); w1.z = pk2(sb[4], sb[5]); w1.w = pk2(sb[6], sb[7]);
                bf16* p = MG + (size_t)row * 4096 + 128 * t + lc;
                *(v4u*)p = w0; *(v4u*)(p + 2048) = w1;
            }
    }
    __device__ __forceinline__ void operator()(const f32x4 (&acc)[2][2][4][2], const Unit& u, int wr, int wc, int fr, int fq) const {
        const int colt = u.pn * 256;
        const int row0 = u.pm * 256 + wr * 64 + fr, lc = wc * 32 + 8 * fq;
        f32x4 bv[2][2];
        if (colt >= 7168) {
            const int t = (colt - 7168) >> 8;
#pragma unroll
            for (int n = 0; n < 2; ++n) { bv[0][n] = *(const f32x4*)(bias + 7168 + 128 * t + lc + 4 * n); bv[1][n] = *(const f32x4*)(bias + 7168 + D + 128 * t + lc + 4 * n); }
            body_mix(acc, t, row0, lc, bv);
            return;
        }
#pragma unroll
        for (int bj = 0; bj < 2; ++bj)
#pragma unroll
            for (int n = 0; n < 2; ++n) bv[bj][n] = *(const f32x4*)(bias + colt + lc + bj * 128 + 4 * n);
        int mode, ldc, c0; bf16* base;
        if (colt < 2048)      { mode = 0; base = U;  ldc = 2048; c0 = colt; }
        else if (colt < 4096) { mode = 1; base = LG; ldc = 2048; c0 = colt - 2048; }
        else if (colt < 6144) { mode = 0; base = Q;  ldc = 2048; c0 = colt - 4096; }
        else if (colt < 6656) { mode = 0; base = Kb; ldc = 512;  c0 = colt - 6144; }
        else                  { mode = 0; base = Vt; ldc = 512;  c0 = colt - 6656; }
        if (mode == 0) body<0>(acc, base, ldc, c0, row0, lc, bv);
        else body<1>(acc, base, ldc, c0, row0, lc, bv);
    }
};
struct EpiMerge {
    static constexpr bool PERM = true, AFTER_DRAIN = false, DUAL = true;
    const bf16* MG; bf16* OUT;
    __device__ __forceinline__ void mid(f32x4 (&acc)[2][2][4][2], const Unit& u, int wr, int wc, int fr, int fq) const {
        const int row0 = u.pm * 256 + wr * 64 + fr, col0 = u.pn * 256 + wc * 32 + 8 * fq;
#pragma unroll
        for (int ai = 0; ai < 2; ++ai) {
            v4u gg[8];
#pragma unroll
            for (int m = 0; m < 4; ++m)
#pragma unroll
                for (int bj = 0; bj < 2; ++bj) gg[2 * m + bj] = *(const v4u*)(MG + (size_t)(row0 + ai * 128 + m * 16) * 4096 + col0 + bj * 128);
            asm volatile("" : "+v"(gg[0]), "+v"(gg[1]), "+v"(gg[2]), "+v"(gg[3]), "+v"(gg[4]), "+v"(gg[5]), "+v"(gg[6]), "+v"(gg[7]));
#pragma unroll
            for (int m = 0; m < 4; ++m)
#pragma unroll
                for (int bj = 0; bj < 2; ++bj) { const v4u g = gg[2 * m + bj];
                    f32x4 r0, r1;
                    r0[0] = bflo(g.x); r0[1] = bfhi(g.x); r0[2] = bflo(g.y); r0[3] = bfhi(g.y); r1[0] = bflo(g.z); r1[1] = bfhi(g.z); r1[2] = bflo(g.w); r1[3] = bfhi(g.w);
                    acc[ai][bj][m][0] *= r0; acc[ai][bj][m][1] *= r1; }
        }
    }
    __device__ __forceinline__ void operator()(const f32x4 (&acc)[2][2][4][2], const Unit& u, int wr, int wc, int fr, int fq) const {
        const int row0 = u.pm * 256 + wr * 64 + fr, col0 = u.pn * 256 + wc * 32 + 8 * fq;
#pragma unroll
        for (int ai = 0; ai < 2; ++ai) {
            v4u g[4][2];
#pragma unroll
            for (int m = 0; m < 4; ++m)
#pragma unroll
                for (int bj = 0; bj < 2; ++bj) g[m][bj] = *(const v4u*)(MG + (size_t)(row0 + ai * 128 + m * 16) * 4096 + 2048 + col0 + bj * 128);
            asm volatile("" : "+v"(g[0][0]), "+v"(g[0][1]), "+v"(g[1][0]), "+v"(g[1][1]), "+v"(g[2][0]), "+v"(g[2][1]), "+v"(g[3][0]), "+v"(g[3][1]));
#pragma unroll
            for (int m = 0; m < 4; ++m)
#pragma unroll
                for (int bj = 0; bj < 2; ++bj) {
                    const v4u gg = g[m][bj];
                    f32x4 v0 = acc[ai][bj][m][0], v1 = acc[ai][bj][m][1];
                    v0[0] *= bflo(gg.x); v0[1] *= bfhi(gg.x); v0[2] *= bflo(gg.y); v0[3] *= bfhi(gg.y);
                    v1[0] *= bflo(gg.z); v1[1] *= bfhi(gg.z); v1[2] *= bflo(gg.w); v1[3] *= bfhi(gg.w);
                    v4u w; w.x = pk2(v0[0], v0[1]); w.y = pk2(v0[2], v0[3]); w.z = pk2(v1[0], v1[1]); w.w = pk2(v1[2], v1[3]);
                    *(v4u*)(OUT + (size_t)(row0 + ai * 128 + m * 16) * 2048 + col0 + bj * 128) = w;
                }
        }
    }
};
struct EpiRes {
    static constexpr bool PERM = true, AFTER_DRAIN = false, DUAL = false;
    const void* src; bf16* dst; const float* gvec; int src_f32;
    __device__ __forceinline__ void operator()(const f32x4 (&acc)[2][2][4][2], const Unit& u, int wr, int wc, int fr, int fq) const {
        const int row0 = u.pm * 256 + wr * 64 + fr, col0 = u.pn * 256 + wc * 32 + 8 * fq;
        const float* g = gvec + (u.pm >> 4) * (NMOD * D);
        f32x4 gv[2][2];
#pragma unroll
        for (int bj = 0; bj < 2; ++bj)
#pragma unroll
            for (int n = 0; n < 2; ++n) gv[bj][n] = *(const f32x4*)(g + col0 + bj * 128 + 4 * n);
        if (src_f32) {
            const float* s = (const float*)src;
#pragma unroll
            for (int ai = 0; ai < 2; ++ai)
#pragma unroll
                for (int mh = 0; mh < 2; ++mh) {
                    f32x4 xs[2][2][2];
#pragma unroll
                    for (int mm = 0; mm < 2; ++mm)
#pragma unroll
                        for (int bj = 0; bj < 2; ++bj)
#pragma unroll
                            for (int n = 0; n < 2; ++n) xs[mm][bj][n] = *(const f32x4*)(s + (size_t)(row0 + ai * 128 + (2 * mh + mm) * 16) * D + col0 + bj * 128 + 4 * n);
                    asm volatile("" : "+v"(xs[0][0][0]), "+v"(xs[0][0][1]), "+v"(xs[0][1][0]), "+v"(xs[0][1][1]), "+v"(xs[1][0][0]), "+v"(xs[1][0][1]), "+v"(xs[1][1][0]), "+v"(xs[1][1][1]));
#pragma unroll
                    for (int mm = 0; mm < 2; ++mm)
#pragma unroll
                        for (int bj = 0; bj < 2; ++bj) { const int m = 2 * mh + mm;
                            const f32x4 x0 = xs[mm][bj][0] + gv[bj][0] * acc[ai][bj][m][0], x1 = xs[mm][bj][1] + gv[bj][1] * acc[ai][bj][m][1];
                            v4u w; w.x = pk2(x0[0], x0[1]); w.y = pk2(x0[2], x0[3]); w.z = pk2(x1[0], x1[1]); w.w = pk2(x1[2], x1[3]);
                            *(v4u*)(dst + (size_t)(row0 + ai * 128 + m * 16) * D + col0 + bj * 128) = w; }
                }
        } else {
            const bf16* s = (const bf16*)src;
#pragma unroll
            for (int ai = 0; ai < 2; ++ai) {
                v4u xs[4][2];
#pragma unroll
                for (int m = 0; m < 4; ++m)
#pragma unroll
                    for (int bj = 0; bj < 2; ++bj) xs[m][bj] = *(const v4u*)(s + (size_t)(row0 + ai * 128 + m * 16) * D + col0 + bj * 128);
                asm volatile("" : "+v"(xs[0][0]), "+v"(xs[0][1]), "+v"(xs[1][0]), "+v"(xs[1][1]), "+v"(xs[2][0]), "+v"(xs[2][1]), "+v"(xs[3][0]), "+v"(xs[3][1]));
#pragma unroll
                for (int m = 0; m < 4; ++m)
#pragma unroll
                    for (int bj = 0; bj < 2; ++bj) { const v4u t = xs[m][bj];
                        f32x4 x0, x1;
                        x0[0] = bflo(t.x); x0[1] = bfhi(t.x); x0[2] = bflo(t.y); x0[3] = bfhi(t.y); x1[0] = bflo(t.z); x1[1] = bfhi(t.z); x1[2] = bflo(t.w); x1[3] = bfhi(t.w);
                        x0 += gv[bj][0] * acc[ai][bj][m][0]; x1 += gv[bj][1] * acc[ai][bj][m][1];
                        v4u w; w.x = pk2(x0[0], x0[1]); w.y = pk2(x0[2], x0[3]); w.z = pk2(x1[0], x1[1]); w.w = pk2(x1[2], x1[3]);
                        *(v4u*)(dst + (size_t)(row0 + ai * 128 + m * 16) * D + col0 + bj * 128) = w; }
            }
        }
    }
};
struct EpiSwiglu {
    static constexpr bool PERM = true, AFTER_DRAIN = false, DUAL = false;
    bf16* HID;
    __device__ __forceinline__ void operator()(const f32x4 (&acc)[2][2][4][2], const Unit& u, int wr, int wc, int fr, int fq) const {
        const int row0 = u.pm * 256 + wr * 64 + fr, col0 = u.pn * 128 + wc * 32 + 8 * fq;
#pragma unroll
        for (int ai = 0; ai < 2; ++ai)
#pragma unroll
            for (int m = 0; m < 4; ++m) {
                f32x4 o0, o1;
#pragma unroll
                for (int j = 0; j < 4; ++j) { const float g0 = acc[ai][0][m][0][j], g1 = acc[ai][0][m][1][j];
                    o0[j] = g0 * sigmoid_f(g0) * acc[ai][1][m][0][j]; o1[j] = g1 * sigmoid_f(g1) * acc[ai][1][m][1][j]; }
                v4u w; w.x = pk2(o0[0], o0[1]); w.y = pk2(o0[2], o0[3]); w.z = pk2(o1[0], o1[1]); w.w = pk2(o1[2], o1[3]);
                *(v4u*)(HID + (size_t)(row0 + ai * 128 + m * 16) * FFN + col0) = w;
            }
    }
};


__device__ __forceinline__ void transpose_item(const float* W, int K, int N, bf16* WT, int k0, int n0, int drow0, LAS float* scr, int lane) {
#pragma unroll 8
    for (int i = 0; i < 32; ++i) { const int kk = 2 * i + (lane >> 5); scr[kk * 33 + (lane & 31)] = W[(size_t)(k0 + kk) * N + n0 + (lane & 31)]; }
    LDS_WAIT(); asm volatile("" ::: "memory");
    const int c = lane & 7;
#pragma unroll
    for (int j = 0; j < 4; ++j) { const int n = (lane >> 3) + 8 * j; const LAS float* s = scr + (8 * c) * 33 + n;
        v4u o; o.x = pk2(s[0 * 33], s[1 * 33]); o.y = pk2(s[2 * 33], s[3 * 33]); o.z = pk2(s[4 * 33], s[5 * 33]); o.w = pk2(s[6 * 33], s[7 * 33]);
        *(v4u*)(WT + (size_t)(drow0 + n) * K + k0 + 8 * c) = o; }
    LDS_WAIT(); asm volatile("" ::: "memory");
}
__device__ __forceinline__ void transpose_mat(const float* W, int K, int N, bf16* WT, int item, LAS float* scr, int lane, int perm) {
    const int nblk = N / 32, kb = item / nblk, nb = item % nblk, n0 = 32 * nb;
    int drow0 = n0;
    if (perm == 1) { drow0 = (n0 < FFN) ? 256 * (n0 >> 7) + (n0 & 127) : 256 * ((n0 - FFN) >> 7) + 128 + ((n0 - FFN) & 127); }
    if (perm == 2 && n0 >= 7168) { const int c = n0 - 7168;
        drow0 = (c < D) ? 7168 + 256 * (c >> 7) + (c & 127) : 7168 + 256 * ((c - D) >> 7) + 128 + ((c - D) & 127); }
    transpose_item(W, K, N, WT, 64 * kb, n0, drow0, scr, lane);
}

__device__ __forceinline__ void norm_row_bf16(const float* xrow, bf16* orow, const float* g, const float* shift, const float* scale, int lane) {
    const f32x4* xr = (const f32x4*)xrow + lane;
    f32x4 v[8]; float s = 0.f;
#pragma unroll
    for (int j = 0; j < 8; ++j) { v[j] = xr[64 * j]; s += (v[j].x * v[j].x + v[j].y * v[j].y) + (v[j].z * v[j].z + v[j].w * v[j].w); }
    const float inv = 1.0f / sqrtf(wave_sum(s) * (1.f / D) + EPS);
    v2u* o8 = (v2u*)orow + lane;
#pragma unroll
    for (int j = 0; j < 8; ++j) {
        const f32x4 gg = ((const f32x4*)g)[lane + 64 * j], sh = ((const f32x4*)shift)[lane + 64 * j], sc = ((const f32x4*)scale)[lane + 64 * j];
        const f32x4 hh = (v[j] * inv) * gg * (sc + 1.0f) + sh;
        v2u w; w.x = pk2(hh.x, hh.y); w.y = pk2(hh.z, hh.w); o8[64 * j] = w;
    }
}
__device__ __forceinline__ void norm_row_bf16in(const bf16* xrow, bf16* orow, const float* g, const float* shift, const float* scale, int lane) {
    const v4u* xr = (const v4u*)xrow + lane;
    float v[4][8]; float s = 0.f;
#pragma unroll
    for (int j = 0; j < 4; ++j) { const v4u t = xr[64 * j];
        v[j][0] = bflo(t.x); v[j][1] = bfhi(t.x); v[j][2] = bflo(t.y); v[j][3] = bfhi(t.y); v[j][4] = bflo(t.z); v[j][5] = bfhi(t.z); v[j][6] = bflo(t.w); v[j][7] = bfhi(t.w);
#pragma unroll
        for (int e = 0; e < 8; ++e) s += v[j][e] * v[j][e]; }
    const float inv = 1.0f / sqrtf(wave_sum(s) * (1.f / D) + EPS);
    v4u* o16 = (v4u*)orow + lane;
#pragma unroll
    for (int j = 0; j < 4; ++j) {
        float hh[8];
#pragma unroll
        for (int q = 0; q < 2; ++q) {
            const f32x4 gg = ((const f32x4*)g)[2 * lane + 128 * j + q], sh = ((const f32x4*)shift)[2 * lane + 128 * j + q], sc = ((const f32x4*)scale)[2 * lane + 128 * j + q];
#pragma unroll
            for (int e = 0; e < 4; ++e) hh[4 * q + e] = (v[j][4 * q + e] * inv) * gg[e] * (sc[e] + 1.0f) + sh[e];
        }
        v4u w; w.x = pk2(hh[0], hh[1]); w.y = pk2(hh[2], hh[3]); w.z = pk2(hh[4], hh[5]); w.w = pk2(hh[6], hh[7]); o16[64 * j] = w;
    }
}
__device__ __forceinline__ void final_norm_row(const bf16* xrow, float* orow, const float* g, int lane) {
    const v4u* xr = (const v4u*)xrow + lane;
    float v[4][8]; float s = 0.f;
#pragma unroll
    for (int j = 0; j < 4; ++j) { const v4u t = xr[64 * j];
        v[j][0] = bflo(t.x); v[j][1] = bfhi(t.x); v[j][2] = bflo(t.y); v[j][3] = bfhi(t.y); v[j][4] = bflo(t.z); v[j][5] = bfhi(t.z); v[j][6] = bflo(t.w); v[j][7] = bfhi(t.w);
#pragma unroll
        for (int e = 0; e < 8; ++e) s += v[j][e] * v[j][e]; }
    const float inv = 1.0f / sqrtf(wave_sum(s) * (1.f / D) + EPS);
#pragma unroll
    for (int j = 0; j < 4; ++j)
#pragma unroll
        for (int q = 0; q < 2; ++q) { const f32x4 gg = ((const f32x4*)g)[2 * lane + 128 * j + q]; f32x4 o;
#pragma unroll
            for (int e = 0; e < 4; ++e) o[e] = (v[j][4 * q + e] * inv) * gg[e];
            ((f32x4*)orow)[2 * lane + 128 * j + q] = o; }
}

#define MFMA32(a, b, c) __builtin_amdgcn_mfma_f32_32x32x16_bf16((a), (b), (c), 0, 0, 0)
__device__ __forceinline__ int crow(int reg, int h) { return (reg & 3) + 8 * (reg >> 2) + 4 * h; }
#define FENCE8(a) asm volatile("" : "+v"((a)[0]), "+v"((a)[1]), "+v"((a)[2]), "+v"((a)[3]), "+v"((a)[4]), "+v"((a)[5]), "+v"((a)[6]), "+v"((a)[7]))
__device__ __forceinline__ void attn_subblock(const LAS unsigned char* Ks, const LAS unsigned char* Vs, const bf16x8 (&bq)[8], bf16x8 (&bqn)[8], const bf16* qn, bool PREFETCH, bf16* orow, int t0, int n, float sink2, int r, int h) {
    constexpr int KRS = 272, VRS = 320;
    const int kt0 = t0 >> 5;
        f32x16 X[5];
        bf16x8 kf[2][8];
        {   const LAS unsigned char* kp = Ks + (32 * kt0 + r) * KRS + 16 * h;
#pragma unroll
            for (int ks = 0; ks < 8; ++ks) kf[0][ks] = *(const LAS bf16x8*)(kp + 32 * ks); }
#pragma unroll
        for (int kk = 0; kk < 5; ++kk) {
            if (kk < 4) { const LAS unsigned char* kp = Ks + (32 * (kt0 + kk + 1) + r) * KRS + 16 * h;
#pragma unroll
                for (int ks = 0; ks < 8; ++ks) kf[(kk + 1) & 1][ks] = *(const LAS bf16x8*)(kp + 32 * ks); }
            FENCE8(kf[kk & 1]);
#pragma unroll
            for (int i = 0; i < 16; ++i) X[kk][i] = 0.f;
#pragma unroll
            for (int ks = 0; ks < 8; ++ks) X[kk] = MFMA32(kf[kk & 1][ks], bq[ks], X[kk]);
        }
        if (PREFETCH) {
#pragma unroll
            for (int ks = 0; ks < 8; ++ks) bqn[ks] = *(const bf16x8*)(qn + 16 * ks); }
        const int qi = t0 + r; float mraw = -__builtin_inff();
#pragma unroll
        for (int kk = 0; kk < 5; ++kk) {
            const bool tile_ok = (n > 0) || (kt0 + kk >= 4);
#pragma unroll
            for (int i = 0; i < 16; ++i) { const int kw = 32 * (kt0 + kk) + crow(i, h);
                bool valid = tile_ok;
                if (kk == 0) valid = valid && (kw > qi);
                if (kk == 4) valid = valid && (kw <= qi + 128);
                const float s = valid ? X[kk][i] : -__builtin_inff(); X[kk][i] = s; mraw = fmaxf(mraw, s); }
        }
        mraw = fmaxf(mraw, __shfl_xor(mraw, 32));
        const float mx = fmaxf(sink2, mraw * SC2);
        float sum = 0.f;
#pragma unroll
        for (int kk = 0; kk < 5; ++kk)
#pragma unroll
            for (int i = 0; i < 16; ++i) { const float p = __builtin_amdgcn_exp2f(__builtin_fmaf(X[kk][i], SC2, -mx)); X[kk][i] = p; sum += p; }
        sum += __shfl_xor(sum, 32);
        const float inv = 1.0f / (sum + __builtin_amdgcn_exp2f(sink2 - mx));
        f32x16 O[4];
#pragma unroll
        for (int dt = 0; dt < 4; ++dt)
#pragma unroll
            for (int i = 0; i < 16; ++i) O[dt][i] = 0.f;
#pragma unroll
        for (int kk = 0; kk < 5; ++kk) {
            v4u av[8];
            const LAS unsigned char* vp = Vs + (32 * (kt0 + kk) + 4 * h + ((r >> 2) & 3)) * VRS + (16 * ((r >> 4) & 1) + 4 * (r & 3)) * 2;
#pragma unroll
            for (int s2 = 0; s2 < 2; ++s2)
#pragma unroll
                for (int dt = 0; dt < 4; ++dt) {
                    const v2u lo = __builtin_bit_cast(v2u, __builtin_amdgcn_ds_read_tr16_b64_v4i16((LAS v4i16_t*)(vp + 16 * s2 * VRS + 64 * dt)));
                    const v2u hi = __builtin_bit_cast(v2u, __builtin_amdgcn_ds_read_tr16_b64_v4i16((LAS v4i16_t*)(vp + 16 * s2 * VRS + 64 * dt + 8 * VRS)));
                    v4u a; a.x = lo.x; a.y = lo.y; a.z = hi.x; a.w = hi.y; av[4 * s2 + dt] = a; }
            FENCE8(av);
#pragma unroll
            for (int s2 = 0; s2 < 2; ++s2) {
                v4u pw; pw.x = pk2(X[kk][8 * s2 + 0], X[kk][8 * s2 + 1]); pw.y = pk2(X[kk][8 * s2 + 2], X[kk][8 * s2 + 3]);
                pw.z = pk2(X[kk][8 * s2 + 4], X[kk][8 * s2 + 5]); pw.w = pk2(X[kk][8 * s2 + 6], X[kk][8 * s2 + 7]);
                const bf16x8 pb = __builtin_bit_cast(bf16x8, pw);
#pragma unroll
                for (int dt = 0; dt < 4; ++dt) O[dt] = MFMA32(__builtin_bit_cast(bf16x8, av[4 * s2 + dt]), pb, O[dt]);
            }
        }
#pragma unroll
        for (int dt = 0; dt < 4; ++dt)
#pragma unroll
            for (int g4 = 0; g4 < 4; ++g4) { v2u w; w.x = pk2(O[dt][4 * g4] * inv, O[dt][4 * g4 + 1] * inv); w.y = pk2(O[dt][4 * g4 + 2] * inv, O[dt][4 * g4 + 3] * inv);
                *(v2u*)(orow + 32 * dt + 8 * g4 + 4 * h) = w; }
}
__device__ __forceinline__ void attn_unit(LAS unsigned char* lds, int b, int n, int hkv, const bf16* QA, bf16* OA, const bf16* Kb, const bf16* Vt, const float* sinks_l, int tid, int wave, int lane) {
    constexpr int KRS = 272, VRS = 320;
    LAS unsigned char* Ks = lds; LAS unsigned char* Vs = lds + 256 * KRS;
    const int blk0 = b * SEQ + n * 128, prev0 = n > 0 ? blk0 - 128 : blk0;
    const int g = wave >> 1, rh = wave & 1, head = hkv * 4 + g, r = lane & 31, h = lane >> 5;
    bf16x8 bqA[8], bqB[8];
    {   const bf16* q0 = QA + (size_t)(blk0 + 64 * rh + r) * D + head * 128 + 8 * h;
#pragma unroll
        for (int ks = 0; ks < 8; ++ks) bqA[ks] = *(const bf16x8*)(q0 + 16 * ks); }
    {
        v4u kv[8], vv[8];
#pragma unroll
        for (int i = 0; i < 8; ++i) { const int row = (tid >> 4) + 32 * i, ch = tid & 15; const int tok = row < 128 ? prev0 + row : blk0 + row - 128;
            kv[i] = *(const v4u*)(Kb + (size_t)tok * 512 + hkv * 128 + ch * 8); }
#pragma unroll
        for (int i = 0; i < 8; ++i) { const int row = (tid >> 4) + 32 * i, ch = tid & 15; const int tok = row < 128 ? prev0 + row : blk0 + row - 128;
            vv[i] = *(const v4u*)(Vt + (size_t)tok * 512 + hkv * 128 + ch * 8); }
        FENCE8(kv);
#pragma unroll
        for (int i = 0; i < 8; ++i) { const int row = (tid >> 4) + 32 * i, ch = tid & 15; *(LAS v4u*)(Ks + row * KRS + ch * 16) = kv[i]; }
        FENCE8(vv);
#pragma unroll
        for (int i = 0; i < 8; ++i) { const int row = (tid >> 4) + 32 * i, ch = tid & 15; *(LAS v4u*)(Vs + row * VRS + ch * 16) = vv[i]; }
    }
    const float sink2 = sinks_l[head] * LOG2E;
    FENCE8(bqA);
    __syncthreads();
#pragma unroll 1
    for (int sb = 0; sb < 2; ++sb) {
        const size_t rowoff = (size_t)(blk0 + 64 * rh + 32 * sb + r) * D + head * 128;
        attn_subblock(Ks, Vs, bqA, bqB, QA + rowoff + (size_t)32 * D + 8 * h, sb == 0, OA + rowoff, 64 * rh + 32 * sb, n, sink2, r, h);
        if (sb == 0) {
#pragma unroll
            for (int ks = 0; ks < 8; ++ks) bqA[ks] = bqB[ks]; }
    }
    __syncthreads();
}

__device__ __forceinline__ void lru_load_rows(v4u (&dst)[11], const bf16* U, int b, int s, int tq, int chan0) {
#pragma unroll
    for (int i = 0; i < 11; ++i) { const int pos = 256 * s + 8 * tq - 3 + i; v4u v; v.x = 0u; v.y = 0u; v.z = 0u; v.w = 0u;
        if (pos >= 0 && pos < SEQ) v = *(const v4u*)(U + (size_t)(b * SEQ + pos) * D + chan0);
        dst[i] = v; }
}
__device__ __forceinline__ void lru_seq(LAS unsigned char* lds, int b, int hd, int ct, const bf16* U, const bf16* LG, bf16* YL,
                                        const float* conv_w, const float* conv_b, const float* ba, const float* bx, const float* lam, const bf16* WAt, const bf16* WXt,
                                        int tid, int wave, int lane) {
    constexpr int RS = 272, TS = 80;
    LAS unsigned char* UCs = lds; LAS unsigned char* WAs = lds + 256 * RS; LAS unsigned char* WXs = WAs + 32 * RS;
    LAS float* EX = (LAS float*)(WXs + 32 * RS);
    LAS float* CW = EX + 512;
    LAS unsigned char* GLs = (LAS unsigned char*)(CW + 640);
    LAS unsigned char* YTs = GLs + 256 * TS;
    { const int row = tid >> 4, chk = tid & 15;
        *(LAS v4u*)(WAs + row * RS + chk * 16) = *(const v4u*)(WAt + (size_t)(hd * 128 + 32 * ct + row) * 128 + chk * 8);
        *(LAS v4u*)(WXs + row * RS + chk * 16) = *(const v4u*)(WXt + (size_t)(hd * 128 + 32 * ct + row) * 128 + chk * 8); }
    for (int i = tid; i < 640; i += NWAVES * 64) { const int k = i >> 7, c = i & 127; CW[i] = (k < 4) ? conv_w[k * D + hd * 128 + c] : conv_b[hd * 128 + c]; }
    const int c8 = tid & 15, tq = tid >> 4, chan0 = hd * 128 + c8 * 8;
    const int r = lane & 31, h = lane >> 5, ch = hd * 128 + 32 * ct + r;
    const float bav = ba[ch], bxv = bx[ch];
    const float sp8 = 8.0f * LOG2E * log1pf(expf(-lam[ch]));
    const int grow = tid >> 2, gq = tid & 3;
    float carry = 0.f;
    v4u raw[11], glr[2];
    lru_load_rows(raw, U, b, 0, tq, chan0);
#pragma unroll
    for (int q = 0; q < 2; ++q) glr[q] = *(const v4u*)(LG + (size_t)(b * SEQ + grow + 128 * q) * D + hd * 128 + 32 * ct + gq * 8);
    __syncthreads();
#pragma unroll 1
    for (int s = 0; s < 16; ++s) {
        {
            f32x4 cwv[5][2];
#pragma unroll
            for (int k = 0; k < 5; ++k) { cwv[k][0] = *(const LAS f32x4*)(CW + k * 128 + c8 * 8); cwv[k][1] = *(const LAS f32x4*)(CW + k * 128 + c8 * 8 + 4); }
#pragma unroll
            for (int j = 0; j < 8; ++j) {
                f32x4 o0 = cwv[4][0], o1 = cwv[4][1];
#pragma unroll
                for (int k = 0; k < 4; ++k) { const v4u v = raw[j + k];
                    o0[0] += cwv[k][0][0] * bflo(v.x); o0[1] += cwv[k][0][1] * bfhi(v.x); o0[2] += cwv[k][0][2] * bflo(v.y); o0[3] += cwv[k][0][3] * bfhi(v.y);
                    o1[0] += cwv[k][1][0] * bflo(v.z); o1[1] += cwv[k][1][1] * bfhi(v.z); o1[2] += cwv[k][1][2] * bflo(v.w); o1[3] += cwv[k][1][3] * bfhi(v.w); }
                v4u w; w.x = pk2(o0[0], o0[1]); w.y = pk2(o0[2], o0[3]); w.z = pk2(o1[0], o1[1]); w.w = pk2(o1[2], o1[3]);
                *(LAS v4u*)(UCs + (8 * tq + j) * RS + c8 * 16) = w;
            }
#pragma unroll
            for (int q = 0; q < 2; ++q) *(LAS v4u*)(GLs + (grow + 128 * q) * TS + gq * 16) = glr[q];
        }
        if (s < 15) {
            const bf16* nb = U + (size_t)(b * SEQ + 256 * (s + 1) + 8 * tq - 3) * D + chan0;
#pragma unroll
            for (int i = 0; i < 11; ++i) raw[i] = *(const v4u*)(nb + (size_t)i * D);
#pragma unroll
            for (int q = 0; q < 2; ++q) glr[q] = *(const v4u*)(LG + (size_t)(b * SEQ + 256 * (s + 1) + grow + 128 * q) * D + hd * 128 + 32 * ct + gq * 8);
        }
        __syncthreads();
        f32x16 ga, gx;
#pragma unroll
        for (int i = 0; i < 16; ++i) { ga[i] = 0.f; gx[i] = 0.f; }
        {   const LAS unsigned char* ap = UCs + (32 * wave + r) * RS + 16 * h;
            const LAS unsigned char* wap = WAs + r * RS + 16 * h;
            const LAS unsigned char* wxp = WXs + r * RS + 16 * h;
#pragma unroll
            for (int ks = 0; ks < 8; ++ks) { const bf16x8 a = *(const LAS bf16x8*)(ap + 32 * ks);
                ga = MFMA32(a, *(const LAS bf16x8*)(wap + 32 * ks), ga); gx = MFMA32(a, *(const LAS bf16x8*)(wxp + 32 * ks), gx); } }
        float P[16], Hl[16];
#pragma unroll
        for (int i = 0; i < 16; i += 2) {
            typedef float f2 __attribute__((ext_vector_type(2)));
            f2 ucv; ucv.x = bf2f(*(const LAS bf16*)(UCs + (32 * wave + crow(i, h)) * RS + (32 * ct + r) * 2)); ucv.y = bf2f(*(const LAS bf16*)(UCs + (32 * wave + crow(i + 1, h)) * RS + (32 * ct + r) * 2));
            f2 za; za.x = ga[i]; za.y = ga[i + 1]; f2 zx; zx.x = gx[i]; zx.y = gx[i + 1];
            za = (za + bav) * (-LOG2E); zx = (zx + bxv) * (-LOG2E);
            f2 ea; ea.x = __builtin_amdgcn_exp2f(za.x); ea.y = __builtin_amdgcn_exp2f(za.y);
            f2 ex; ex.x = __builtin_amdgcn_exp2f(zx.x); ex.y = __builtin_amdgcn_exp2f(zx.y);
            ea = ea + 1.0f; ex = ex + 1.0f;
            f2 rg; rg.x = __builtin_amdgcn_rcpf(ea.x); rg.y = __builtin_amdgcn_rcpf(ea.y);
            f2 ig; ig.x = __builtin_amdgcn_rcpf(ex.x); ig.y = __builtin_amdgcn_rcpf(ex.y);
            const f2 la = rg * (-sp8);
            f2 a; a.x = __builtin_amdgcn_exp2f(la.x); a.y = __builtin_amdgcn_exp2f(la.y);
            const f2 om = 1.0f - a * a;
            f2 beta; beta.x = __builtin_amdgcn_sqrtf(om.x); beta.y = __builtin_amdgcn_sqrtf(om.y);
            const f2 inp = beta * ig * ucv;
            P[i] = a.x; P[i + 1] = a.y; Hl[i] = inp.x; Hl[i + 1] = inp.y;
        }
        float Ar[4], Hr[4], ArP[4], HrP[4], cin0[4], apre[4];
#pragma unroll
        for (int g = 0; g < 4; ++g) {
#pragma unroll
            for (int e = 1; e < 4; ++e) { Hl[4 * g + e] = P[4 * g + e] * Hl[4 * g + e - 1] + Hl[4 * g + e]; P[4 * g + e] = P[4 * g + e] * P[4 * g + e - 1]; }
            Ar[g] = P[4 * g + 3]; Hr[g] = Hl[4 * g + 3];
            ArP[g] = __shfl_xor(Ar[g], 32); HrP[g] = __shfl_xor(Hr[g], 32);
        }
        float cur = 0.f, curA = 1.f;
#pragma unroll
        for (int g = 0; g < 4; ++g) {
            const float A0 = h ? ArP[g] : Ar[g], H0 = h ? HrP[g] : Hr[g], A1 = h ? Ar[g] : ArP[g], H1 = h ? Hr[g] : HrP[g];
            const float c0 = cur, p0 = curA; cur = A0 * cur + H0; curA *= A0;
            const float c1 = cur, p1 = curA; cur = A1 * cur + H1; curA *= A1;
            cin0[g] = h ? c1 : c0; apre[g] = h ? p1 : p0;
        }
        if (h == 0) { EX[wave * 64 + r] = curA; EX[wave * 64 + 32 + r] = cur; }
        __syncthreads();
        float cin = carry, mycin = 0.f;
#pragma unroll
        for (int w = 0; w < 8; ++w) { const float a = EX[w * 64 + r], hh = EX[w * 64 + 32 + r]; if (w == wave) mycin = cin; cin = a * cin + hh; }
        carry = cin;
#pragma unroll
        for (int g = 0; g < 4; ++g) {
            const float cg_ = cin0[g] + apre[g] * mycin;
#pragma unroll
            for (int e = 0; e < 4; ++e) {
                const int trow = 32 * wave + 8 * g + 4 * h + e;
                const float hv = Hl[4 * g + e] + P[4 * g + e] * cg_;
                const float gate = bf2f(*(const LAS bf16*)(GLs + trow * TS + r * 2));
                *(LAS bf16*)(YTs + trow * TS + r * 2) = (bf16)(pk2(hv * gate, 0.f) & 0xffffu);
            }
        }
        __syncthreads();
#pragma unroll
        for (int q = 0; q < 2; ++q) *(v4u*)(YL + (size_t)(b * SEQ + 256 * s + grow + 128 * q) * D + hd * 128 + 32 * ct + gq * 8) = *(const LAS v4u*)(YTs + (grow + 128 * q) * TS + gq * 16);
    }
    __syncthreads();
}

#define XB_TMO      128
#define XB_XCNT(j)  (256  + 64 * (j))
#define XB_XSUB(j)  (1280 + 64 * (j))
#define XB_XGEN(j)  (2304 + 64 * (j))
#define XB_TOP      3328
#define XB_TOPGEN   3392
#define XCD_BAR_WORDS 3456
#define XB_SPIN_CAP (1u << 21)
__device__ __forceinline__ unsigned xb_ld(unsigned* p)              { return __hip_atomic_load(p, __ATOMIC_RELAXED, __HIP_MEMORY_SCOPE_AGENT); }
__device__ __forceinline__ unsigned xb_add(unsigned* p, unsigned v) { return __hip_atomic_fetch_add(p, v, __ATOMIC_RELAXED, __HIP_MEMORY_SCOPE_AGENT); }
__device__ __forceinline__ unsigned xb_xcc_id() { return (unsigned)__builtin_amdgcn_s_getreg((3 << 11) | 20) & 0xFu; }
#define XB_SPIN(cond, bar) do { unsigned _sp = 0; while (cond) { __builtin_amdgcn_s_sleep(1); \
    if ((++_sp & 255u) == 0u) { if (xb_ld(&(bar)[XB_TMO])) break; if (_sp > XB_SPIN_CAP) { atomicAdd(&(bar)[XB_TMO], 1u); break; } } } } while (0)
struct XcdBarrier { unsigned* bar; unsigned x; volatile LAS unsigned* st; };
__device__ __forceinline__ XcdBarrier xcd_barrier_post(unsigned* bar, volatile LAS unsigned* st) {
    XcdBarrier b; b.bar = bar; b.x = xb_xcc_id(); b.st = st;
    if (threadIdx.x == 0) st[2] = xb_add(&bar[XB_XCNT(b.x)], 1u);
    return b;
}
__device__ __forceinline__ void xcd_barrier_complete(unsigned* bar, unsigned x, unsigned& nloc, unsigned& nx) {
    const unsigned G = gridDim.x * gridDim.y * gridDim.z;
    unsigned sum, cnt, mine, sp = 0u;
    for (;;) {
        sum = 0u; cnt = 0u; mine = 0u;
#pragma unroll
        for (unsigned j = 0; j < 16; ++j) { const unsigned c = xb_ld(&bar[XB_XCNT(j)]); sum += c; cnt += (c > 0u) ? 1u : 0u; mine = (j == x) ? c : mine; }
        if (sum == G) break;
        __builtin_amdgcn_s_sleep(1);
        if ((++sp & 255u) == 0u) { if (xb_ld(&bar[XB_TMO])) break; if (sp > XB_SPIN_CAP) { atomicAdd(&bar[XB_TMO], 1u); break; } }
    }
    nloc = mine > 0u ? mine : 1u; nx = cnt > 0u ? cnt : 1u;
}
__device__ __forceinline__ void xcd_barrier(const XcdBarrier& b) {
    asm volatile("s_waitcnt vmcnt(0)" ::: "memory");
    __syncthreads();
    if (threadIdx.x == 0) {
        unsigned* bar = b.bar;
        __builtin_amdgcn_s_waitcnt(0);
        unsigned nloc = b.st[0], nx = b.st[1];
        if (nloc == 0u) { xcd_barrier_complete(bar, b.x, nloc, nx); b.st[0] = nloc; b.st[1] = nx; }
        const unsigned old = xb_add(&bar[XB_XSUB(b.x)], 1u);
        const unsigned gen = old / nloc;
        if (old + 1u == (gen + 1u) * nloc) {
            __builtin_amdgcn_fence(__ATOMIC_RELEASE, "agent");
            asm volatile("s_waitcnt vmcnt(0)" ::: "memory");
            const unsigned og = xb_add(&bar[XB_TOP], 1u);
            const unsigned tg = og / nx;
            if (og + 1u == (tg + 1u) * nx) xb_add(&bar[XB_TOPGEN], 1u);
            else XB_SPIN(xb_ld(&bar[XB_TOPGEN]) == tg, bar);
            __builtin_amdgcn_fence(__ATOMIC_ACQUIRE, "agent");
            xb_add(&bar[XB_XGEN(b.x)], 1u);
            asm volatile("s_waitcnt vmcnt(0)" ::: "memory");
        } else {
            XB_SPIN(xb_ld(&bar[XB_XGEN(b.x)]) == gen, bar);
            __builtin_amdgcn_fence(__ATOMIC_ACQUIRE, "agent");
            asm volatile("s_waitcnt vmcnt(0)" ::: "memory");
        }
    }
    __syncthreads();
}

struct Args { const float* in[22]; float* out; unsigned char* ws; };
enum { I_X = 0, I_C, I_ADAW, I_ADAB, I_N1G, I_WIN, I_BIN, I_CONVW, I_CONVB, I_WA, I_BA, I_WX, I_BX, I_LAM, I_SINKS, I_WLO, I_WAO, I_WO, I_N2G, I_WFI, I_WFO, I_FG };

__global__ void __launch_bounds__(NWAVES * 64, 2) mk_fwd(Args args) {
    extern __shared__ __attribute__((aligned(16))) unsigned char lds_raw[];
    cg::grid_group grid = cg::this_grid();
    LAS unsigned char* lds = (LAS unsigned char*)lds_raw;
#define GSYNC() xcd_barrier(xbar)
#define FRESH_TID() int tid_f = threadIdx.x; asm volatile("" : "+v"(tid_f)); const int tid = tid_f, lane = tid_f & 63; (void)tid; (void)lane
    const int wave = __builtin_amdgcn_readfirstlane((int)threadIdx.x >> 6);
    const int G = gridDim.x, bx = blockIdx.x;
    const int vcu = (G % 8 == 0) ? (bx % 8) * (G / 8) + bx / 8 : bx;
    const int gw = vcu * NWAVES + wave, NGW = G * NWAVES;
    unsigned char* ws = args.ws;
    volatile LAS unsigned* xst = (volatile LAS unsigned*)(lds + LDS_BYTES - 64);
    if (threadIdx.x == 0) { xst[0] = 0u; xst[1] = 0u; xst[2] = 0u; xst[3] = 0u; }
    __syncthreads();
    const XcdBarrier xbar = xcd_barrier_post((unsigned*)(ws + WS_BAR), xst);
    float* MODP = (float*)(ws + WS_MODP); float* MOD = (float*)(ws + WS_MOD);
    bf16* Hb = (bf16*)(ws + WS_H); bf16* Ub = (bf16*)(ws + WS_U); bf16* LGb = (bf16*)(ws + WS_LG); bf16* Qb = (bf16*)(ws + WS_Q);
    bf16* Kbuf = (bf16*)(ws + WS_K); bf16* Vtb = (bf16*)(ws + WS_VT); bf16* MGb = (bf16*)(ws + WS_MG); bf16* HIDb = (bf16*)(ws + WS_HID);
    float* xout = args.out; bf16* XB = (bf16*)(ws + WS_XB);

    {
        FRESH_TID();
        LAS float* scr = (LAS float*)(lds + wave * 16384);
        for (int it = gw; it < 2 * 48 * 16; it += NGW) {
            const int ks = it & 15, nb = (it >> 4) % 48, l = it / (16 * 48);
            const float* cp = args.in[I_C];
            float sv[4][2];
#pragma unroll
            for (int b = 0; b < 4; ++b)
#pragma unroll
                for (int q = 0; q < 2; ++q) { const float c = cp[b * D + ks * 128 + q * 64 + lane]; sv[b][q] = c * sigmoid_f(c); }
            const float* wp = args.in[I_ADAW] + ((size_t)l * D + ks * 128) * (NMOD * D) + nb * 256 + lane * 4;
            f32x4 acc[4];
#pragma unroll
            for (int b = 0; b < 4; ++b) acc[b] = (f32x4){0.f, 0.f, 0.f, 0.f};
#pragma unroll
            for (int q = 0; q < 2; ++q)
#pragma unroll 8
                for (int kk = 0; kk < 64; ++kk) {
                    const f32x4 w = *(const f32x4*)(wp + (size_t)(q * 64 + kk) * (NMOD * D));
#pragma unroll
                    for (int b = 0; b < 4; ++b) acc[b] += w * __shfl(sv[b][q], kk);
                }
#pragma unroll
            for (int b = 0; b < 4; ++b) *(f32x4*)(MODP + ((size_t)((l * 16 + ks) * 4 + b)) * (NMOD * D) + nb * 256 + lane * 4) = acc[b];
        }
        constexpr int I_IN = 32 * (CIN / 32), I_SQ = 32 * (D / 32), I_FO = (FFN / 64) * (D / 32), I_LR = 16 * 2 * 4;
        constexpr int PER_L = 2 * I_IN + 3 * I_SQ + I_FO + 2 * I_LR;
        for (int it = gw; it < 2 * PER_L; it += NGW) {
            const int l = it / PER_L; int rr = it % PER_L;
            unsigned char* wl = ws + WS_W + (size_t)l * W_LAYER;
            if (rr < I_IN) { transpose_mat(args.in[I_WIN] + (size_t)l * D * CIN, D, CIN, (bf16*)(wl + WO_IN), rr, scr, lane, 2); continue; } rr -= I_IN;
            if (rr < I_IN) { transpose_mat(args.in[I_WFI] + (size_t)l * D * CIN, D, CIN, (bf16*)(wl + WO_FI), rr, scr, lane, 1); continue; } rr -= I_IN;
            if (rr < I_SQ) { transpose_mat(args.in[I_WLO] + (size_t)l * D * D, D, D, (bf16*)(wl + WO_LO), rr, scr, lane, 0); continue; } rr -= I_SQ;
            if (rr < I_SQ) { transpose_mat(args.in[I_WAO] + (size_t)l * D * D, D, D, (bf16*)(wl + WO_AO), rr, scr, lane, 0); continue; } rr -= I_SQ;
            if (rr < I_SQ) { transpose_mat(args.in[I_WO] + (size_t)l * D * D, D, D, (bf16*)(wl + WO_O), rr, scr, lane, 0); continue; } rr -= I_SQ;
            if (rr < I_FO) { transpose_mat(args.in[I_WFO] + (size_t)l * FFN * D, FFN, D, (bf16*)(wl + WO_FO), rr, scr, lane, 0); continue; } rr -= I_FO;
            {
                const bool second = rr >= I_LR; if (second) rr -= I_LR;
                const int hd = rr >> 3, sub = rr & 7;
                const float* src = args.in[second ? I_WX : I_WA] + ((size_t)l * 16 + hd) * 128 * 128;
                bf16* dst = (bf16*)(wl + (second ? WO_WX : WO_WA)) + (size_t)hd * 128 * 128;
                transpose_mat(src, 128, 128, dst, sub, scr, lane, 0);
            }
        }
    }
    GSYNC();
    if (args.ws == nullptr) grid.sync();
    int vb = bx;
    {   if (threadIdx.x == 0) { unsigned* bar = (unsigned*)(ws + WS_BAR); bool ok = (G % 8 == 0);
            for (unsigned j = 0; j < 16; ++j) { const unsigned c = xb_ld(&bar[XB_XCNT(j)]); ok = ok && (c == (j < 8 ? (unsigned)(G / 8) : 0u)); }
            xst[3] = ok ? (xbar.x + 8u * xst[2]) : (unsigned)bx; }
        __syncthreads();
        vb = __builtin_amdgcn_readfirstlane((int)xst[3]); }
    const int vgw = ((G % 8 == 0) ? (vb % 8) * (G / 8) + vb / 8 : vb) * NWAVES + wave;
    { FRESH_TID();
    for (int i = bx * (NWAVES * 64) + tid; i < 2 * 4 * NMOD * D; i += G * NWAVES * 64) {
        const int n = i % (NMOD * D), lb = i / (NMOD * D), l = lb >> 2, b = lb & 3;
        float s = args.in[I_ADAB][l * NMOD * D + n];
#pragma unroll
        for (int ks = 0; ks < 16; ++ks) s += MODP[((size_t)((l * 16 + ks) * 4 + b)) * (NMOD * D) + n];
        MOD[i] = s;
    } }
    GSYNC();

#pragma unroll 1
    for (int l = 0; l < DEPTH; ++l) {
        const float* modl = MOD + (size_t)l * 4 * NMOD * D;
        unsigned char* wl = ws + WS_W + (size_t)l * W_LAYER;
        { FRESH_TID();
        for (int m = vgw; m < M; m += NGW) { const float* mb = modl + (m >> 12) * (NMOD * D);
            if (l == 0) norm_row_bf16(args.in[I_X] + (size_t)m * D, Hb + (size_t)m * D, args.in[I_N1G] + l * D, mb, mb + D, lane);
            else norm_row_bf16in(XB + (size_t)m * D, Hb + (size_t)m * D, args.in[I_N1G] + l * D, mb, mb + D, lane); } }
        GSYNC();
        {   pg8::Gemm g{Hb, (const bf16*)(wl + WO_IN), M, CIN, D}; pg8::StaticOrder S; S.init(M, CIN, G, vb);
            EpiIn E{args.in[I_BIN] + (size_t)l * CIN, Ub, LGb, Qb, Kbuf, Vtb, MGb};
            pg8::gemm_phase<EpiIn, pg8::StaticOrder, true, true>(lds, g, S, E); }
        GSYNC();
        {
            FRESH_TID();
            for (int u = vb; u < 4 * 16 * 4; u += G) {
                const int xc = u & 7, rk = u >> 3, ct = rk & 3, bh = xc + 8 * (rk >> 2), hd = bh & 15, b = bh >> 4;
                lru_seq(lds, b, hd, ct, Ub, LGb, Hb, args.in[I_CONVW] + (size_t)l * 4 * D, args.in[I_CONVB] + l * D, args.in[I_BA] + l * D, args.in[I_BX] + l * D,
                        args.in[I_LAM] + l * D, (const bf16*)(wl + WO_WA), (const bf16*)(wl + WO_WX), tid, wave, lane); }
            for (int u = vb; u < 4 * 32 * 4; u += G) { const int hkv = u & 3, n = (u >> 2) & 31, b = u >> 7;
                attn_unit(lds, b, n, hkv, Qb, Qb, Kbuf, Vtb, args.in[I_SINKS] + l * 16, tid, wave, lane); }
        }
        GSYNC();
        {   pg8::Gemm g{Hb, (const bf16*)(wl + WO_LO), M, D, D, Qb, (const bf16*)(wl + WO_AO)}; pg8::StaticOrder S; S.init(M, D, G, vb);
            EpiMerge E{MGb, Ub};
            pg8::gemm_phase<EpiMerge, pg8::StaticOrder, true, true>(lds, g, S, E); }
        GSYNC();
        {   pg8::Gemm g{Ub, (const bf16*)(wl + WO_O), M, D, D}; pg8::StaticOrder S; S.init(M, D, G, vb);
            EpiRes E{(l == 0) ? (const void*)args.in[I_X] : (const void*)XB, XB, modl + 2 * D, (l == 0) ? 1 : 0};
            pg8::gemm_phase<EpiRes, pg8::StaticOrder, true, true>(lds, g, S, E); }
        GSYNC();
        { FRESH_TID();
        for (int m = vgw; m < M; m += NGW) { const float* mb = modl + (m >> 12) * (NMOD * D);
            norm_row_bf16in(XB + (size_t)m * D, Hb + (size_t)m * D, args.in[I_N2G] + l * D, mb + 3 * D, mb + 4 * D, lane); } }
        GSYNC();
        {   pg8::Gemm g{Hb, (const bf16*)(wl + WO_FI), M, CIN, D}; pg8::StaticOrder S; S.init(M, CIN, G, vb);
            EpiSwiglu E{HIDb};
            pg8::gemm_phase<EpiSwiglu, pg8::StaticOrder, true, true>(lds, g, S, E); }
        GSYNC();
        {   pg8::Gemm g{HIDb, (const bf16*)(wl + WO_FO), M, D, FFN}; pg8::StaticOrder S; S.init(M, D, G, vb);
            EpiRes E{(const void*)XB, XB, modl + 5 * D, 0};
            pg8::gemm_phase<EpiRes, pg8::StaticOrder, true, true>(lds, g, S, E); }
        GSYNC();
    }
    FRESH_TID();
    for (int m = vgw; m < M; m += NGW) final_norm_row(XB + (size_t)m * D, xout + (size_t)m * D, args.in[I_FG], lane);
}

extern "C" void kernel_launch(void* const* d_in, const int* in_sizes, int n_in, void* d_out, int out_size, void* d_ws, size_t ws_size, hipStream_t stream) {
    static int grid = 0;
    if (grid == 0) {
        if (n_in != 22 || in_sizes[0] != M * D || out_size != M * D || ws_size < WS_END) { fprintf(stderr, "kernel_launch: unexpected shapes (n_in %d, in0 %d, out %d, ws %zu); nothing launched\n", n_in, n_in > 0 ? in_sizes[0] : -1, out_size, ws_size); grid = -1; return; }
        int dev = 0, cus = 0, per_cu = 0;
        if (hipGetDevice(&dev) != hipSuccess || hipDeviceGetAttribute(&cus, hipDeviceAttributeMultiprocessorCount, dev) != hipSuccess) { grid = -1; return; }
        if (hipFuncSetAttribute((const void*)mk_fwd, hipFuncAttributeMaxDynamicSharedMemorySize, LDS_BYTES) != hipSuccess) { fprintf(stderr, "kernel_launch: hipFuncSetAttribute failed\n"); grid = -1; return; }
        if (hipOccupancyMaxActiveBlocksPerMultiprocessor(&per_cu, (const void*)mk_fwd, NWAVES * 64, LDS_BYTES) != hipSuccess || per_cu < 1) { fprintf(stderr, "kernel_launch: occupancy query gave %d\n", per_cu); per_cu = 1; }
        (void)hipGetLastError();
        grid = cus * per_cu;
    }
    if (grid < 0) return;
    Args a{};
    for (int i = 0; i < 22; ++i) a.in[i] = (const float*)d_in[i];
    a.out = (float*)d_out; a.ws = (unsigned char*)d_ws;
    if (hipMemsetAsync((char*)d_ws + WS_BAR, 0, BAR_ZERO_BYTES, stream) != hipSuccess) { fprintf(stderr, "kernel_launch: memset failed\n"); return; }
    void* kargs[] = {&a};
    hipError_t e = hipLaunchCooperativeKernel((const void*)mk_fwd, dim3(grid), dim3(NWAVES * 64), kargs, LDS_BYTES, stream);
    if (e != hipSuccess) fprintf(stderr, "kernel_launch: cooperative launch failed: %s (grid %d)\n", hipGetErrorString(e), grid);
}
```

```cpp
#include <hip/hip_runtime.h>
#include <hip/hip_cooperative_groups.h>
#include <cstdio>
#include <cstdint>
namespace cg = cooperative_groups;
namespace pg8 {
#define PG8_LAS __attribute__((address_space(3)))
typedef unsigned short bf16_t;
typedef short bf16x8 __attribute__((ext_vector_type(8)));
typedef float f32x4 __attribute__((ext_vector_type(4)));
typedef unsigned u32x4 __attribute__((ext_vector_type(4)));
constexpr int BM = 256, BK = 64, HALF = 128, HTB = HALF * BK * 2  , STAGE_BYTES = 8 * HTB, NXCD = 8, WGM = 8;

__host__ __device__ __forceinline__ int lds_byte(int r, int c) { const int st = (r >> 4) * 2 + (c >> 5), rr = r & 15, cc = c & 31, ob = rr * 64 + cc * 2; return st * 1024 + (ob ^ (((ob >> 9) & 1) << 5)); }
__host__ __device__ __forceinline__ void stage_rc(int b, int& R, int& C) { const int st = b / 1024, sb = b % 1024, swz = sb ^ (((sb >> 9) & 1) << 5); R = (st >> 1) * 16 + swz / 64; C = (st & 1) * 32 + (swz % 64) / 2; }
__host__ __device__ __forceinline__ int perm32(int rho) { const int n = rho >> 4, i = rho & 15; return 8 * (i >> 2) + 4 * n + (i & 3); }

struct Unit { int pm, pn; };
struct Gemm { const bf16_t* A; const bf16_t* Bt; int M, N, K; const bf16_t* A2 = nullptr; const bf16_t* Bt2 = nullptr; };

struct StaticOrder {
    int nM, nN, nwg, G, c;
    __host__ __device__ void init(int M, int N, int G_, int c_) { nM = M / BM; nN = N / BM; nwg = nM * nN; G = G_; c = c_; }
    __host__ __device__ bool next(int i, Unit& u) const {
        const long L = (long)i * G + c; if (L >= nwg) return false;
        int wgid = (int)L; { const int q = nwg / NXCD, r = nwg % NXCD, xcd = wgid % NXCD, off = wgid / NXCD; wgid = (xcd < r ? xcd * (q + 1) : r * (q + 1) + (xcd - r) * q) + off; }
        const int nig = WGM * nN, gid = wgid / nig, fm = gid * WGM, gsz = (nM - fm) < WGM ? (nM - fm) : WGM;
        u.pm = fm + ((wgid % nig) % gsz); u.pn = (wgid % nig) / gsz; return true;
    }
    __device__ __forceinline__ void a_ready(const Unit&) const {}
    __device__ __forceinline__ void done(const Unit&) const {}
};
__device__ __forceinline__ unsigned cvt_pk_bf16(float lo, float hi) { unsigned r; asm volatile("v_cvt_pk_bf16_f32 %0, %1, %2" : "=v"(r) : "v"(lo), "v"(hi)); return r; }
typedef float f32x2 __attribute__((ext_vector_type(2)));
template <class Epi, class Sched, bool ALIGN_EPI = false, bool SP2 = false>
__device__ __forceinline__ void gemm_phase(PG8_LAS unsigned char* lds, const Gemm g, const Sched& S, const Epi& E) {
    int tid_ = threadIdx.x; asm volatile("" : "+v"(tid_));
    const int tid = tid_, wid = __builtin_amdgcn_readfirstlane(tid >> 6), lane = tid & 63, wr = wid >> 2, wc = wid & 3, fr = lane & 15, fq = lane >> 4;
    const int K = g.K, nt1 = K / BK, nt = Epi::DUAL ? 2 * nt1 : nt1;
    unsigned voffA[2], voffB[2];
#pragma unroll
    for (int i = 0; i < 2; ++i) { int R, C; stage_rc(tid * 16 + i * 8192, R, C); const int Rb = Epi::PERM ? ((R & ~31) + perm32(R & 31)) : R;
        voffA[i] = (unsigned)(R * K + C) * 2u; voffB[i] = (unsigned)(Rb * K + C) * 2u; }
    const size_t kstep = (size_t)(BK * 2);
    const size_t hstep = (size_t)HALF * K * 2;
    const size_t tstep = 2 * hstep;
    const unsigned ldsw = (unsigned)wid * 1024u;
    const int aoff = lds_byte(wr * 64 + fr, fq * 8), boff = lds_byte(wc * 32 + fr, fq * 8);
#define PG8_SA(b, h) (((b) * 2 + (h)) * HTB)
#define PG8_SB(b, h) ((4 + (b) * 2 + (h)) * HTB)
#define PG8_STAGE(bufoff, gbase, voff) do { _Pragma("unroll") for (int _i = 0; _i < 2; ++_i) \
        __builtin_amdgcn_global_load_lds((const unsigned*)((const char*)(gbase) + (voff)[_i]), (PG8_LAS unsigned*)(lds + (bufoff) + ldsw + _i * 8192), 16, 0, 0); } while (0)
#define PG8_LDA(dst, b, h) do { _Pragma("unroll") for (int m = 0; m < 4; ++m) _Pragma("unroll") for (int k = 0; k < 2; ++k) dst[m][k] = *(const PG8_LAS bf16x8*)(lds + PG8_SA(b, h) + aoff + m * 2048 + k * 1024); } while (0)
#define PG8_LDB(dst, b, h) do { _Pragma("unroll") for (int n = 0; n < 2; ++n) _Pragma("unroll") for (int k = 0; k < 2; ++k) dst[n][k] = *(const PG8_LAS bf16x8*)(lds + PG8_SB(b, h) + boff + n * 2048 + k * 1024); } while (0)
#define PG8_MMA(ai, bj, At, Bt) do { __builtin_amdgcn_s_setprio(1); _Pragma("unroll") for (int m = 0; m < 4; ++m) _Pragma("unroll") for (int n = 0; n < 2; ++n) _Pragma("unroll") for (int k = 0; k < 2; ++k) \
        acc[ai][bj][m][n] = __builtin_amdgcn_mfma_f32_16x16x32_bf16(Bt[n][k], At[m][k], acc[ai][bj][m][n], 0, 0, 0); __builtin_amdgcn_s_setprio(0); } while (0)
#define PG8_WAIT_V(n) asm volatile("s_waitcnt vmcnt(" #n ")" ::: "memory")
#define PG8_WAIT_L(n) asm volatile("s_waitcnt lgkmcnt(" #n ")" ::: "memory")
#define PG8_BAR __builtin_amdgcn_s_barrier()
#define PG8_SCHED __builtin_amdgcn_sched_barrier(0)
    Unit cur, nxt; int ui = 0;
    if (!S.next(0, cur)) return;
    f32x4 acc[2][2][4][2];
#pragma unroll
    for (int a = 0; a < 2; ++a)
#pragma unroll
        for (int b = 0; b < 2; ++b)
#pragma unroll
            for (int m = 0; m < 4; ++m)
#pragma unroll
                for (int n = 0; n < 2; ++n) acc[a][b][m][n] = (f32x4){0.f, 0.f, 0.f, 0.f};
    bf16x8 At[4][2], B0[2][2], B1[2][2];
    const char* cA = (const char*)g.A + (size_t)cur.pm * tstep; const char* cB = (const char*)g.Bt + (size_t)cur.pn * tstep;
    const char* cA2 = Epi::DUAL ? (const char*)g.A2 + (size_t)cur.pm * tstep : cA; const char* cB2 = Epi::DUAL ? (const char*)g.Bt2 + (size_t)cur.pn * tstep : cB;
    S.a_ready(cur);
    if constexpr (SP2) {
        PG8_STAGE(PG8_SB(0, 0), cB, voffB); PG8_STAGE(PG8_SB(0, 1), cB + hstep, voffB); PG8_STAGE(PG8_SA(0, 0), cA, voffA); PG8_STAGE(PG8_SA(0, 1), cA + hstep, voffA);
        if (wr == 1) PG8_BAR;
        PG8_WAIT_V(2); PG8_BAR;
        PG8_STAGE(PG8_SB(1, 0), cB + kstep, voffB); PG8_STAGE(PG8_SA(1, 0), cA + kstep, voffA); PG8_STAGE(PG8_SB(1, 1), cB + hstep + kstep, voffB);
        PG8_WAIT_V(6); PG8_BAR;
    } else {
        PG8_STAGE(PG8_SB(0, 0), cB, voffB); PG8_STAGE(PG8_SA(0, 0), cA, voffA); PG8_STAGE(PG8_SB(0, 1), cB + hstep, voffB); PG8_STAGE(PG8_SA(0, 1), cA + hstep, voffA);
        if (wr == 1) PG8_BAR;
        PG8_WAIT_V(4); PG8_BAR;
        PG8_STAGE(PG8_SB(1, 0), cB + kstep, voffB); PG8_STAGE(PG8_SA(1, 0), cA + kstep, voffA); PG8_STAGE(PG8_SB(1, 1), cB + hstep + kstep, voffB);
        PG8_WAIT_V(6); PG8_BAR;
    }
    for (;;) {
        const bool has_next = S.next(ui + 1, nxt);
        const char* nA = has_next ? (const char*)g.A + (size_t)nxt.pm * tstep : cA; const char* nB = has_next ? (const char*)g.Bt + (size_t)nxt.pn * tstep : cB;
        for (int t = 0; t < nt; t += 2) {
            const bool last = (t == nt - 2);
            const char* tA1 = cA + (size_t)(t + 1) * kstep; const char* tA2 = cA + (size_t)(t + 2) * kstep; const char* tB2 = cB + (size_t)(t + 2) * kstep;
            if constexpr (Epi::DUAL) {
                if (t >= nt1) tA1 = cA2 + (size_t)(t + 1 - nt1) * kstep;
                if (t + 2 >= nt1) { tA2 = cA2 + (size_t)(t + 2 - nt1) * kstep; tB2 = cB2 + (size_t)(t + 2 - nt1) * kstep; }
                if (t == nt1) { int fr_m = fr, fq_m = fq; asm volatile("" : "+v"(fr_m), "+v"(fq_m)); E.mid(acc, cur, wr, wc, fr_m, fq_m); }
            }
            const char* a1 = tA1;
            const char* a2 = last ? nA : tA2; const char* b2 = last ? nB : tB2;
            const char* a3 = a2 + kstep; const char* b3 = b2 + kstep;
            if (last && has_next) S.a_ready(nxt);
            if constexpr (SP2) {
            PG8_LDB(B0, 0, 0); PG8_LDB(B1, 0, 1); PG8_SCHED; PG8_LDA(At, 0, 0); PG8_STAGE(PG8_SA(1, 1), a1 + hstep, voffA);
            PG8_WAIT_V(8); PG8_WAIT_L(0); PG8_BAR; PG8_MMA(0, 0, At, B0); PG8_MMA(0, 1, At, B1); PG8_BAR; PG8_SCHED;
            PG8_LDA(At, 0, 1); PG8_STAGE(PG8_SB(0, 0), b2, voffB); PG8_STAGE(PG8_SB(0, 1), b2 + hstep, voffB); PG8_STAGE(PG8_SA(0, 0), a2, voffA);
            PG8_WAIT_V(8); PG8_WAIT_L(0); PG8_BAR; PG8_MMA(1, 0, At, B0); PG8_MMA(1, 1, At, B1); PG8_BAR; PG8_SCHED;
            PG8_LDB(B0, 1, 0); PG8_LDB(B1, 1, 1); PG8_SCHED; PG8_LDA(At, 1, 0); PG8_STAGE(PG8_SA(0, 1), a2 + hstep, voffA);
            PG8_WAIT_V(8); PG8_WAIT_L(0); PG8_BAR; PG8_MMA(0, 0, At, B0); PG8_MMA(0, 1, At, B1); PG8_BAR; PG8_SCHED;
            PG8_LDA(At, 1, 1); PG8_STAGE(PG8_SB(1, 0), b3, voffB); PG8_STAGE(PG8_SB(1, 1), b3 + hstep, voffB); PG8_STAGE(PG8_SA(1, 0), a3, voffA);
            PG8_WAIT_V(8); PG8_WAIT_L(0); PG8_BAR; PG8_MMA(1, 0, At, B0); PG8_MMA(1, 1, At, B1); PG8_BAR; PG8_SCHED;
            } else {
            PG8_LDB(B0, 0, 0); PG8_SCHED; PG8_LDA(At, 0, 0); PG8_STAGE(PG8_SA(1, 1), a1 + hstep, voffA);
            PG8_WAIT_L(8); PG8_BAR; PG8_WAIT_L(0); PG8_MMA(0, 0, At, B0); PG8_BAR; PG8_SCHED;
            PG8_LDB(B1, 0, 1); PG8_STAGE(PG8_SB(0, 0), b2, voffB);
            PG8_BAR; PG8_WAIT_L(0); PG8_MMA(0, 1, At, B1); PG8_BAR;
            PG8_LDA(At, 0, 1); PG8_STAGE(PG8_SA(0, 0), a2, voffA);
            PG8_BAR; PG8_WAIT_L(0); PG8_MMA(1, 0, At, B0); PG8_BAR; PG8_SCHED;
            PG8_STAGE(PG8_SB(0, 1), b2 + hstep, voffB);
            PG8_WAIT_V(6); PG8_BAR; PG8_MMA(1, 1, At, B1); PG8_BAR;
            PG8_LDB(B0, 1, 0); PG8_SCHED; PG8_LDA(At, 1, 0); PG8_STAGE(PG8_SA(0, 1), a2 + hstep, voffA);
            PG8_WAIT_L(8); PG8_BAR; PG8_WAIT_L(0); PG8_MMA(0, 0, At, B0); PG8_BAR; PG8_SCHED;
            PG8_LDB(B1, 1, 1); PG8_STAGE(PG8_SB(1, 0), b3, voffB);
            PG8_BAR; PG8_WAIT_L(0); PG8_MMA(0, 1, At, B1); PG8_BAR;
            PG8_LDA(At, 1, 1); PG8_STAGE(PG8_SA(1, 0), a3, voffA);
            PG8_BAR; PG8_WAIT_L(0); PG8_MMA(1, 0, At, B0); PG8_BAR; PG8_SCHED;
            PG8_STAGE(PG8_SB(1, 1), b3 + hstep, voffB);
            PG8_WAIT_V(6); PG8_BAR; PG8_MMA(1, 1, At, B1); PG8_BAR;
            }
        }
        if constexpr (ALIGN_EPI) { if (wr == 0) PG8_BAR; }
        if constexpr (!Epi::AFTER_DRAIN) { int fr_e = fr, fq_e = fq; asm volatile("" : "+v"(fr_e), "+v"(fq_e)); E(acc, cur, wr, wc, fr_e, fq_e); S.done(cur); }
        if (!has_next) break;
#pragma unroll
        for (int a = 0; a < 2; ++a)
#pragma unroll
            for (int b = 0; b < 2; ++b)
#pragma unroll
                for (int m = 0; m < 4; ++m)
#pragma unroll
                    for (int n = 0; n < 2; ++n) acc[a][b][m][n] = (f32x4){0.f, 0.f, 0.f, 0.f};
        cur = nxt; cA = nA; cB = nB; ++ui;
        if constexpr (Epi::DUAL) { cA2 = (const char*)g.A2 + (size_t)cur.pm * tstep; cB2 = (const char*)g.Bt2 + (size_t)cur.pn * tstep; }
        if constexpr (ALIGN_EPI) { if (wr == 1) PG8_BAR; }
    }
    PG8_WAIT_V(0);
    if constexpr (!ALIGN_EPI) { if (wr == 0) PG8_BAR; }
    PG8_BAR;
    if constexpr (Epi::AFTER_DRAIN) { E.fused(acc, cur, wr, wc, fr, fq, lds, wid, lane); S.done(cur); }
#undef PG8_SA
#undef PG8_SB
#undef PG8_STAGE
#undef PG8_LDA
#undef PG8_LDB
#undef PG8_MMA
#undef PG8_WAIT_V
#undef PG8_WAIT_L
#undef PG8_BAR
#undef PG8_SCHED
}
}

constexpr int NWAVES = 8;
constexpr int D = 2048, SEQ = 4096, NB = 4, M = NB * SEQ, CIN = 11264, FFN = 5632, NMOD = 6, DEPTH = 2;
constexpr float EPS = 1e-6f, LOG2E = 1.4426950408889634f;
constexpr float SC2 = 0.08838834764831845f * 1.4426950408889634f;

constexpr size_t MiB = 1u << 20;
constexpr size_t WS_BAR = 0, BAR_ZERO_BYTES = 16384;
constexpr size_t WS_MODP = 2 * MiB;
constexpr size_t WS_MOD = 9 * MiB;
constexpr size_t WS_W = 16 * MiB, W_LAYER = 135 * MiB;
constexpr size_t WO_IN = 0, WO_LO = 44 * MiB, WO_AO = 52 * MiB, WO_O = 60 * MiB, WO_FI = 68 * MiB, WO_FO = 112 * MiB, WO_WA = 134 * MiB, WO_WX = 134 * MiB + 512 * 1024;
constexpr size_t WS_H = 288 * MiB;
constexpr size_t WS_U = 352 * MiB, WS_LG = 416 * MiB, WS_Q = 480 * MiB, WS_K = 544 * MiB, WS_VT = 560 * MiB, WS_MG = 576 * MiB;
constexpr size_t WS_HID = 352 * MiB;
constexpr size_t WS_XB = 704 * MiB;
constexpr size_t WS_END = 768 * MiB;
constexpr int LDS_BYTES = 155648;

#define GAS __attribute__((address_space(1)))
#define LAS __attribute__((address_space(3)))
typedef unsigned short bf16;
typedef unsigned v4u __attribute__((ext_vector_type(4)));
typedef unsigned v2u __attribute__((ext_vector_type(2)));
typedef float f32x4 __attribute__((ext_vector_type(4)));
typedef float f32x16 __attribute__((ext_vector_type(16)));
typedef short bf16x8 __attribute__((ext_vector_type(8)));
typedef short s16x4 __attribute__((ext_vector_type(4)));
typedef short v4i16_t __attribute__((ext_vector_type(4)));
typedef __bf16 bf16x2_t __attribute__((ext_vector_type(2)));
typedef float f32x2_t __attribute__((ext_vector_type(2)));
#define LDS_WAIT() asm volatile("s_waitcnt lgkmcnt(0)" ::: "memory")

__device__ __forceinline__ unsigned pk2(float lo, float hi) { f32x2_t v = {lo, hi}; bf16x2_t b = __builtin_convertvector(v, bf16x2_t); return __builtin_bit_cast(unsigned, b); }
__device__ __forceinline__ float bflo(unsigned w) { return __builtin_bit_cast(float, w << 16); }
__device__ __forceinline__ float bfhi(unsigned w) { return __builtin_bit_cast(float, w & 0xffff0000u); }
__device__ __forceinline__ float bf2f(bf16 b) { return __builtin_bit_cast(float, ((unsigned)b) << 16); }
__device__ __forceinline__ float sigmoid_f(float v) { return __builtin_amdgcn_rcpf(1.0f + __builtin_amdgcn_exp2f(-v * LOG2E)); }
__device__ __forceinline__ float gelu_tanh_f(float v) { const float z = 1.5957691216057308f * (v + 0.044715f * v * v * v); return v * sigmoid_f(z); }
__device__ __forceinline__ float wave_sum(float v) {
#pragma unroll
    for (int o = 1; o < 64; o <<= 1) v += __shfl_xor(v, o);
    return v;
}

using pg8::Unit; using pg8::bf16_t;
struct EpiIn {
    static constexpr bool PERM = true, AFTER_DRAIN = false, DUAL = false;
    const float* bias; bf16* U; bf16* LG; bf16* Q; bf16* Kb; bf16* Vt; bf16* MG;
    template <int MODE> __device__ __forceinline__ void body(const f32x4 (&acc)[2][2][4][2], bf16* base, int ldc, int c0, int row0, int lc, const f32x4 (&bv)[2][2]) const {
#pragma unroll
        for (int ai = 0; ai < 2; ++ai)
#pragma unroll
            for (int m = 0; m < 4; ++m) {
                const int row = row0 + ai * 128 + m * 16;
#pragma unroll
                for (int bj = 0; bj < 2; ++bj) {
                    f32x4 v0 = acc[ai][bj][m][0] + bv[bj][0], v1 = acc[ai][bj][m][1] + bv[bj][1];
                    if (MODE == 1) {
#pragma unroll
                        for (int j = 0; j < 4; ++j) { v0[j] = gelu_tanh_f(v0[j]); v1[j] = gelu_tanh_f(v1[j]); }
                    } else if (MODE == 2) {
#pragma unroll
                        for (int j = 0; j < 4; ++j) { v0[j] = sigmoid_f(v0[j]); v1[j] = sigmoid_f(v1[j]); }
                    }
                    v4u w; w.x = pk2(v0[0], v0[1]); w.y = pk2(v0[2], v0[3]); w.z = pk2(v1[0], v1[1]); w.w = pk2(v1[2], v1[3]);
                    if (MODE != 3) {
                        *(v4u*)(base + (size_t)row * ldc + c0 + bj * 128 + lc) = w;
                    } else {
                        const int b = row >> 12, s = row & 4095, cv = c0 + bj * 128 + lc;
                        bf16* p = base + (((size_t)(b * 512 + cv)) << 12) + s;
                        p[0 << 12] = (bf16)(w.x & 0xffffu); p[1 << 12] = (bf16)(w.x >> 16);
                        p[2 << 12] = (bf16)(w.y & 0xffffu); p[3 << 12] = (bf16)(w.y >> 16);
                        p[4 << 12] = (bf16)(w.z & 0xffffu); p[5 << 12] = (bf16)(w.z >> 16);
                        p[6 << 12] = (bf16)(w.w & 0xffffu); p[7 << 12] = (bf16)(w.w >> 16);
                    }
                }
            }
    }
    __device__ __forceinline__ void body_mix(const f32x4 (&acc)[2][2][4][2], int t, int row0, int lc, const f32x4 (&bv)[2][2]) const {
#pragma unroll
        for (int ai = 0; ai < 2; ++ai)
#pragma unroll
            for (int m = 0; m < 4; ++m) {
                const int row = row0 + ai * 128 + m * 16;
                float rt[8], sb[8];
#pragma unroll
                for (int n = 0; n < 2; ++n)
#pragma unroll
                    for (int j = 0; j < 4; ++j) {
                        const float a = acc[ai][0][m][n][j] + bv[0][n][j], b = acc[ai][1][m][n][j] + bv[1][n][j];
                        const float ea = __builtin_amdgcn_exp2f(-a * LOG2E), eb = __builtin_amdgcn_exp2f(-b * LOG2E);
                        sb[4 * n + j] = __builtin_amdgcn_rcpf(1.0f + eb);
                        rt[4 * n + j] = (1.0f + eb) * __builtin_amdgcn_rcpf(1.0f + ea);
                    }
                v4u w0, w1;
                w0.x = pk2(rt[0], rt[1]); w0.y = pk2(rt[2], rt[3]); w0.z = pk2(rt[4], rt[5]); w0.w = pk2(rt[6], rt[7]);
                w1.x = pk2(sb[0], sb[1]); w1.y = pk2(sb[2], sb[3]); w1.z = pk2(sb[4], sb[5]); w1.w = pk2(sb[6], sb[7]);
                bf16* p = MG + (size_t)row * 4096 + 128 * t + lc;
                *(v4u*)p = w0; *(v4u*)(p + 2048) = w1;
            }
    }
    __device__ __forceinline__ void operator()(const f32x4 (&acc)[2][2][4][2], const Unit& u, int wr, int wc, int fr, int fq) const {
        const int colt = u.pn * 256;
        const int row0 = u.pm * 256 + wr * 64 + fr, lc = wc * 32 + 8 * fq;
        f32x4 bv[2][2];
        if (colt >= 7168) {
            const int t = (colt - 7168) >> 8;
#pragma unroll
            for (int n = 0; n < 2; ++n) { bv[0][n] = *(const f32x4*)(bias + 7168 + 128 * t + lc + 4 * n); bv[1][n] = *(const f32x4*)(bias + 7168 + D + 128 * t + lc + 4 * n); }
            body_mix(acc, t, row0, lc, bv);
            return;
        }
#pragma unroll
        for (int bj = 0; bj < 2; ++bj)
#pragma unroll
            for (int n = 0; n < 2; ++n) bv[bj][n] = *(const f32x4*)(bias + colt + lc + bj * 128 + 4 * n);
        int mode, ldc, c0; bf16* base;
        if (colt < 2048)      { mode = 0; base = U;  ldc = 2048; c0 = colt; }
        else if (colt < 4096) { mode = 1; base = LG; ldc = 2048; c0 = colt - 2048; }
        else if (colt < 6144) { mode = 0; base = Q;  ldc = 2048; c0 = colt - 4096; }
        else if (colt < 6656) { mode = 0; base = Kb; ldc = 512;  c0 = colt - 6144; }
        else                  { mode = 0; base = Vt; ldc = 512;  c0 = colt - 6656; }
        if (mode == 0) body<0>(acc, base, ldc, c0, row0, lc, bv);
        else body<1>(acc, base, ldc, c0, row0, lc, bv);
    }
};
struct EpiMerge {
    static constexpr bool PERM = true, AFTER_DRAIN = false, DUAL = true;
    const bf16* MG; bf16* OUT;
    __device__ __forceinline__ void mid(f32x4 (&acc)[2][2][4][2], const Unit& u, int wr, int wc, int fr, int fq) const {
        const int row0 = u.pm * 256 + wr * 64 + fr, col0 = u.pn * 256 + wc * 32 + 8 * fq;
#pragma unroll
        for (int ai = 0; ai < 2; ++ai) {
            v4u gg[8];
#pragma unroll
            for (int m = 0; m < 4; ++m)
#pragma unroll
                for (int bj = 0; bj < 2; ++bj) gg[2 * m + bj] = *(const v4u*)(MG + (size_t)(row0 + ai * 128 + m * 16) * 4096 + col0 + bj * 128);
            asm volatile("" : "+v"(gg[0]), "+v"(gg[1]), "+v"(gg[2]), "+v"(gg[3]), "+v"(gg[4]), "+v"(gg[5]), "+v"(gg[6]), "+v"(gg[7]));
#pragma unroll
            for (int m = 0; m < 4; ++m)
#pragma unroll
                for (int bj = 0; bj < 2; ++bj) { const v4u g = gg[2 * m + bj];
                    f32x4 r0, r1;
                    r0[0] = bflo(g.x); r0[1] = bfhi(g.x); r0[2] = bflo(g.y); r0[3] = bfhi(g.y); r1[0] = bflo(g.z); r1[1] = bfhi(g.z); r1[2] = bflo(g.w); r1[3] = bfhi(g.w);
                    acc[ai][bj][m][0] *= r0; acc[ai][bj][m][1] *= r1; }
        }
    }
    __device__ __forceinline__ void operator()(const f32x4 (&acc)[2][2][4][2], const Unit& u, int wr, int wc, int fr, int fq) const {
        const int row0 = u.pm * 256 + wr * 64 + fr, col0 = u.pn * 256 + wc * 32 + 8 * fq;
#pragma unroll
        for (int ai = 0; ai < 2; ++ai) {
            v4u g[4][2];
#pragma unroll
            for (int m = 0; m < 4; ++m)
#pragma unroll
                for (int bj = 0; bj < 2; ++bj) g[m][bj] = *(const v4u*)(MG + (size_t)(row0 + ai * 128 + m * 16) * 4096 + 2048 + col0 + bj * 128);
            asm volatile("" : "+v"(g[0][0]), "+v"(g[0][1]), "+v"(g[1][0]), "+v"(g[1][1]), "+v"(g[2][0]), "+v"(g[2][1]), "+v"(g[3][0]), "+v"(g[3][1]));
#pragma unroll
            for (int m = 0; m < 4; ++m)
#pragma unroll
                for (int bj = 0; bj < 2; ++bj) {
                    const v4u gg = g[m][bj];
                    f32x4 v0 = acc[ai][bj][m][0], v1 = acc[ai][bj][m][1];
                    v0[0] *= bflo(gg.x); v0[1] *= bfhi(gg.x); v0[2] *= bflo(gg.y); v0[3] *= bfhi(gg.y);
                    v1[0] *= bflo(gg.z); v1[1] *= bfhi(gg.z); v1[2] *= bflo(gg.w); v1[3] *= bfhi(gg.w);
                    v4u w; w.x = pk2(v0[0], v0[1]); w.y = pk2(v0[2], v0[3]); w.z = pk2(v1[0], v1[1]); w.w = pk2(v1[2], v1[3]);
                    *(v4u*)(OUT + (size_t)(row0 + ai * 128 + m * 16) * 2048 + col0 + bj * 128) = w;
                }
        }
    }
};
struct EpiRes {
    static constexpr bool PERM = true, AFTER_DRAIN = false, DUAL = false;
    const void* src; bf16* dst; const float* gvec; int src_f32;
    __device__ __forceinline__ void operator()(const f32x4 (&acc)[2][2][4][2], const Unit& u, int wr, int wc, int fr, int fq) const {
        const int row0 = u.pm * 256 + wr * 64 + fr, col0 = u.pn * 256 + wc * 32 + 8 * fq;
        const float* g = gvec + (u.pm >> 4) * (NMOD * D);
        f32x4 gv[2][2];
#pragma unroll
        for (int bj = 0; bj < 2; ++bj)
#pragma unroll
            for (int n = 0; n < 2; ++n) gv[bj][n] = *(const f32x4*)(g + col0 + bj * 128 + 4 * n);
        if (src_f32) {
            const float* s = (const float*)src;
#pragma unroll
            for (int ai = 0; ai < 2; ++ai)
#pragma unroll
                for (int mh = 0; mh < 2; ++mh) {
                    f32x4 xs[2][2][2];
#pragma unroll
                    for (int mm = 0; mm < 2; ++mm)
#pragma unroll
                        for (int bj = 0; bj < 2; ++bj)
#pragma unroll
                            for (int n = 0; n < 2; ++n) xs[mm][bj][n] = *(const f32x4*)(s + (size_t)(row0 + ai * 128 + (2 * mh + mm) * 16) * D + col0 + bj * 128 + 4 * n);
                    asm volatile("" : "+v"(xs[0][0][0]), "+v"(xs[0][0][1]), "+v"(xs[0][1][0]), "+v"(xs[0][1][1]), "+v"(xs[1][0][0]), "+v"(xs[1][0][1]), "+v"(xs[1][1][0]), "+v"(xs[1][1][1]));
#pragma unroll
                    for (int mm = 0; mm < 2; ++mm)
#pragma unroll
                        for (int bj = 0; bj < 2; ++bj) { const int m = 2 * mh + mm;
                            const f32x4 x0 = xs[mm][bj][0] + gv[bj][0] * acc[ai][bj][m][0], x1 = xs[mm][bj][1] + gv[bj][1] * acc[ai][bj][m][1];
                            v4u w; w.x = pk2(x0[0], x0[1]); w.y = pk2(x0[2], x0[3]); w.z = pk2(x1[0], x1[1]); w.w = pk2(x1[2], x1[3]);
                            *(v4u*)(dst + (size_t)(row0 + ai * 128 + m * 16) * D + col0 + bj * 128) = w; }
                }
        } else {
            const bf16* s = (const bf16*)src;
#pragma unroll
            for (int ai = 0; ai < 2; ++ai) {
                v4u xs[4][2];
#pragma unroll
                for (int m = 0; m < 4; ++m)
#pragma unroll
                    for (int bj = 0; bj < 2; ++bj) xs[m][bj] = *(const v4u*)(s + (size_t)(row0 + ai * 128 + m * 16) * D + col0 + bj * 128);
                asm volatile("" : "+v"(xs[0][0]), "+v"(xs[0][1]), "+v"(xs[1][0]), "+v"(xs[1][1]), "+v"(xs[2][0]), "+v"(xs[2][1]), "+v"(xs[3][0]), "+v"(xs[3][1]));
#pragma unroll
                for (int m = 0; m < 4; ++m)
#pragma unroll
                    for (int bj = 0; bj < 2; ++bj) { const v4u t = xs[m][bj];
                        f32x4 x0, x1;
                        x0[0] = bflo(t.x); x0[1] = bfhi(t.x); x0[2] = bflo(t.y); x0[3] = bfhi(t.y); x1[0] = bflo(t.z); x1[1] = bfhi(t.z); x1[2] = bflo(t.w); x1[3] = bfhi(t.w);
                        x0 += gv[bj][0] * acc[ai][bj][m][0]; x1 += gv[bj][1] * acc[ai][bj][m][1];
                        v4u w; w.x = pk2(x0[0], x0[1]); w.y = pk2(x0[2], x0[3]); w.z = pk2(x1[0], x1[1]); w.w = pk2(x1[2], x1[3]);
                        *(v4u*)(dst + (size_t)(row0 + ai * 128 + m * 16) * D + col0 + bj * 128) = w; }
            }
        }
    }
};
struct EpiSwiglu {
    static constexpr bool PERM = true, AFTER_DRAIN = false, DUAL = false;
    bf16* HID;
    __device__ __forceinline__ void operator()(const f32x4 (&acc)[2][2][4][2], const Unit& u, int wr, int wc, int fr, int fq) const {
        const int row0 = u.pm * 256 + wr * 64 + fr, col0 = u.pn * 128 + wc * 32 + 8 * fq;
#pragma unroll
        for (int ai = 0; ai < 2; ++ai)
#pragma unroll
            for (int m = 0; m < 4; ++m) {
                f32x4 o0, o1;
#pragma unroll
                for (int j = 0; j < 4; ++j) { const float g0 = acc[ai][0][m][0][j], g1 = acc[ai][0][m][1][j];
                    o0[j] = g0 * sigmoid_f(g0) * acc[ai][1][m][0][j]; o1[j] = g1 * sigmoid_f(g1) * acc[ai][1][m][1][j]; }
                v4u w; w.x = pk2(o0[0], o0[1]); w.y = pk2(o0[2], o0[3]); w.z = pk2(o1[0], o1[1]); w.w = pk2(o1[2], o1[3]);
                *(v4u*)(HID + (size_t)(row0 + ai * 128 + m * 16) * FFN + col0) = w;
            }
    }
};


__device__ __forceinline__ void transpose_item(const float* W, int K, int N, bf16* WT, int k0, int n0, int drow0, LAS float* scr, int lane) {
#pragma unroll 8
    for (int i = 0; i < 32; ++i) { const int kk = 2 * i + (lane >> 5); scr[kk * 33 + (lane & 31)] = W[(size_t)(k0 + kk) * N + n0 + (lane & 31)]; }
    LDS_WAIT(); asm volatile("" ::: "memory");
    const int c = lane & 7;
#pragma unroll
    for (int j = 0; j < 4; ++j) { const int n = (lane >> 3) + 8 * j; const LAS float* s = scr + (8 * c) * 33 + n;
        v4u o; o.x = pk2(s[0 * 33], s[1 * 33]); o.y = pk2(s[2 * 33], s[3 * 33]); o.z = pk2(s[4 * 33], s[5 * 33]); o.w = pk2(s[6 * 33], s[7 * 33]);
        *(v4u*)(WT + (size_t)(drow0 + n) * K + k0 + 8 * c) = o; }
    LDS_WAIT(); asm volatile("" ::: "memory");
}
__device__ __forceinline__ void transpose_mat(const float* W, int K, int N, bf16* WT, int item, LAS float* scr, int lane, int perm) {
    const int nblk = N / 32, kb = item / nblk, nb = item % nblk, n0 = 32 * nb;
    int drow0 = n0;
    if (perm == 1) { drow0 = (n0 < FFN) ? 256 * (n0 >> 7) + (n0 & 127) : 256 * ((n0 - FFN) >> 7) + 128 + ((n0 - FFN) & 127); }
    if (perm == 2 && n0 >= 7168) { const int c = n0 - 7168;
        drow0 = (c < D) ? 7168 + 256 * (c >> 7) + (c & 127) : 7168 + 256 * ((c - D) >> 7) + 128 + ((c - D) & 127); }
    transpose_item(W, K, N, WT, 64 * kb, n0, drow0, scr, lane);
}

__device__ __forceinline__ void norm_row_bf16(const float* xrow, bf16* orow, const float* g, const float* shift, const float* scale, int lane) {
    const f32x4* xr = (const f32x4*)xrow + lane;
    f32x4 v[8]; float s = 0.f;
#pragma unroll
    for (int j = 0; j < 8; ++j) { v[j] = xr[64 * j]; s += (v[j].x * v[j].x + v[j].y * v[j].y) + (v[j].z * v[j].z + v[j].w * v[j].w); }
    const float inv = 1.0f / sqrtf(wave_sum(s) * (1.f / D) + EPS);
    v2u* o8 = (v2u*)orow + lane;
#pragma unroll
    for (int j = 0; j < 8; ++j) {
        const f32x4 gg = ((const f32x4*)g)[lane + 64 * j], sh = ((const f32x4*)shift)[lane + 64 * j], sc = ((const f32x4*)scale)[lane + 64 * j];
        const f32x4 hh = (v[j] * inv) * gg * (sc + 1.0f) + sh;
        v2u w; w.x = pk2(hh.x, hh.y); w.y = pk2(hh.z, hh.w); o8[64 * j] = w;
    }
}
__device__ __forceinline__ void norm_row_bf16in(const bf16* xrow, bf16* orow, const float* g, const float* shift, const float* scale, int lane) {
    const v4u* xr = (const v4u*)xrow + lane;
    float v[4][8]; float s = 0.f;
#pragma unroll
    for (int j = 0; j < 4; ++j) { const v4u t = xr[64 * j];
        v[j][0] = bflo(t.x); v[j][1] = bfhi(t.x); v[j][2] = bflo(t.y); v[j][3] = bfhi(t.y); v[j][4] = bflo(t.z); v[j][5] = bfhi(t.z); v[j][6] = bflo(t.w); v[j][7] = bfhi(t.w);
#pragma unroll
        for (int e = 0; e < 8; ++e) s += v[j][e] * v[j][e]; }
    const float inv = 1.0f / sqrtf(wave_sum(s) * (1.f / D) + EPS);
    v4u* o16 = (v4u*)orow + lane;
#pragma unroll
    for (int j = 0; j < 4; ++j) {
        float hh[8];
#pragma unroll
        for (int q = 0; q < 2; ++q) {
            const f32x4 gg = ((const f32x4*)g)[2 * lane + 128 * j + q], sh = ((const f32x4*)shift)[2 * lane + 128 * j + q], sc = ((const f32x4*)scale)[2 * lane + 128 * j + q];
#pragma unroll
            for (int e = 0; e < 4; ++e) hh[4 * q + e] = (v[j][4 * q + e] * inv) * gg[e] * (sc[e] + 1.0f) + sh[e];
        }
        v4u w; w.x = pk2(hh[0], hh[1]); w.y = pk2(hh[2], hh[3]); w.z = pk2(hh[4], hh[5]); w.w = pk2(hh[6], hh[7]); o16[64 * j] = w;
    }
}
__device__ __forceinline__ void final_norm_row(const bf16* xrow, float* orow, const float* g, int lane) {
    const v4u* xr = (const v4u*)xrow + lane;
    float v[4][8]; float s = 0.f;
#pragma unroll
    for (int j = 0; j < 4; ++j) { const v4u t = xr[64 * j];
        v[j][0] = bflo(t.x); v[j][1] = bfhi(t.x); v[j][2] = bflo(t.y); v[j][3] = bfhi(t.y); v[j][4] = bflo(t.z); v[j][5] = bfhi(t.z); v[j][6] = bflo(t.w); v[j][7] = bfhi(t.w);
#pragma unroll
        for (int e = 0; e < 8; ++e) s += v[j][e] * v[j][e]; }
    const float inv = 1.0f / sqrtf(wave_sum(s) * (1.f / D) + EPS);
#pragma unroll
    for (int j = 0; j < 4; ++j)
#pragma unroll
        for (int q = 0; q < 2; ++q) { const f32x4 gg = ((const f32x4*)g)[2 * lane + 128 * j + q]; f32x4 o;
#pragma unroll
            for (int e = 0; e < 4; ++e) o[e] = (v[j][4 * q + e] * inv) * gg[e];
            ((f32x4*)orow)[2 * lane + 128 * j + q] = o; }
}

#define MFMA32(a, b, c) __builtin_amdgcn_mfma_f32_32x32x16_bf16((a), (b), (c), 0, 0, 0)
__device__ __forceinline__ int crow(int reg, int h) { return (reg & 3) + 8 * (reg >> 2) + 4 * h; }
#define FENCE8(a) asm volatile("" : "+v"((a)[0]), "+v"((a)[1]), "+v"((a)[2]), "+v"((a)[3]), "+v"((a)[4]), "+v"((a)[5]), "+v"((a)[6]), "+v"((a)[7]))
__device__ __forceinline__ void attn_subblock(const LAS unsigned char* Ks, const LAS unsigned char* Vs, const bf16x8 (&bq)[8], bf16x8 (&bqn)[8], const bf16* qn, bool PREFETCH, bf16* orow, int t0, int n, float sink2, int r, int h) {
    constexpr int KRS = 272, VRS = 320;
    const int kt0 = t0 >> 5;
        f32x16 X[5];
        bf16x8 kf[2][8];
        {   const LAS unsigned char* kp = Ks + (32 * kt0 + r) * KRS + 16 * h;
#pragma unroll
            for (int ks = 0; ks < 8; ++ks) kf[0][ks] = *(const LAS bf16x8*)(kp + 32 * ks); }
#pragma unroll
        for (int kk = 0; kk < 5; ++kk) {
            if (kk < 4) { const LAS unsigned char* kp = Ks + (32 * (kt0 + kk + 1) + r) * KRS + 16 * h;
#pragma unroll
                for (int ks = 0; ks < 8; ++ks) kf[(kk + 1) & 1][ks] = *(const LAS bf16x8*)(kp + 32 * ks); }
            FENCE8(kf[kk & 1]);
#pragma unroll
            for (int i = 0; i < 16; ++i) X[kk][i] = 0.f;
#pragma unroll
            for (int ks = 0; ks < 8; ++ks) X[kk] = MFMA32(kf[kk & 1][ks], bq[ks], X[kk]);
        }
        if (PREFETCH) {
#pragma unroll
            for (int ks = 0; ks < 8; ++ks) bqn[ks] = *(const bf16x8*)(qn + 16 * ks); }
        const int qi = t0 + r; float mraw = -__builtin_inff();
#pragma unroll
        for (int kk = 0; kk < 5; ++kk) {
            const bool tile_ok = (n > 0) || (kt0 + kk >= 4);
#pragma unroll
            for (int i = 0; i < 16; ++i) { const int kw = 32 * (kt0 + kk) + crow(i, h);
                bool valid = tile_ok;
                if (kk == 0) valid = valid && (kw > qi);
                if (kk == 4) valid = valid && (kw <= qi + 128);
                const float s = valid ? X[kk][i] : -__builtin_inff(); X[kk][i] = s; mraw = fmaxf(mraw, s); }
        }
        mraw = fmaxf(mraw, __shfl_xor(mraw, 32));
        const float mx = fmaxf(sink2, mraw * SC2);
        float sum = 0.f;
        f32x16 O[4];
#pragma unroll
        for (int dt = 0; dt < 4; ++dt)
#pragma unroll
            for (int i = 0; i < 16; ++i) O[dt][i] = 0.f;
#pragma unroll
        for (int kk = 0; kk < 5; ++kk) {
            v4u av[8];
            const LAS unsigned char* vp = Vs + (32 * (kt0 + kk) + 4 * h + ((r >> 2) & 3)) * VRS + (16 * ((r >> 4) & 1) + 4 * (r & 3)) * 2;
#pragma unroll
            for (int s2 = 0; s2 < 2; ++s2)
#pragma unroll
                for (int dt = 0; dt < 4; ++dt) {
                    const v2u lo = __builtin_bit_cast(v2u, __builtin_amdgcn_ds_read_tr16_b64_v4i16((LAS v4i16_t*)(vp + 16 * s2 * VRS + 64 * dt)));
                    const v2u hi = __builtin_bit_cast(v2u, __builtin_amdgcn_ds_read_tr16_b64_v4i16((LAS v4i16_t*)(vp + 16 * s2 * VRS + 64 * dt + 8 * VRS)));
                    v4u a; a.x = lo.x; a.y = lo.y; a.z = hi.x; a.w = hi.y; av[4 * s2 + dt] = a; }
#pragma unroll
            for (int i = 0; i < 16; ++i) { const float p = __builtin_amdgcn_exp2f(__builtin_fmaf(X[kk][i], SC2, -mx)); X[kk][i] = p; sum += p; }
            FENCE8(av);
#pragma unroll
            for (int s2 = 0; s2 < 2; ++s2) {
                v4u pw; pw.x = pk2(X[kk][8 * s2 + 0], X[kk][8 * s2 + 1]); pw.y = pk2(X[kk][8 * s2 + 2], X[kk][8 * s2 + 3]);
                pw.z = pk2(X[kk][8 * s2 + 4], X[kk][8 * s2 + 5]); pw.w = pk2(X[kk][8 * s2 + 6], X[kk][8 * s2 + 7]);
                const bf16x8 pb = __builtin_bit_cast(bf16x8, pw);
#pragma unroll
                for (int dt = 0; dt < 4; ++dt) O[dt] = MFMA32(__builtin_bit_cast(bf16x8, av[4 * s2 + dt]), pb, O[dt]);
            }
        }
        sum += __shfl_xor(sum, 32);
        const float inv = 1.0f / (sum + __builtin_amdgcn_exp2f(sink2 - mx));
#pragma unroll
        for (int dt = 0; dt < 4; ++dt)
#pragma unroll
            for (int g4 = 0; g4 < 4; ++g4) { v2u w; w.x = pk2(O[dt][4 * g4] * inv, O[dt][4 * g4 + 1] * inv); w.y = pk2(O[dt][4 * g4 + 2] * inv, O[dt][4 * g4 + 3] * inv);
                *(v2u*)(orow + 32 * dt + 8 * g4 + 4 * h) = w; }
}
__device__ __forceinline__ void attn_unit(LAS unsigned char* lds, int b, int n, int hkv, const bf16* QA, bf16* OA, const bf16* Kb, const bf16* Vt, const float* sinks_l, int tid, int wave, int lane) {
    constexpr int KRS = 272, VRS = 320;
    LAS unsigned char* Ks = lds; LAS unsigned char* Vs = lds + 256 * KRS;
    const int blk0 = b * SEQ + n * 128, prev0 = n > 0 ? blk0 - 128 : blk0;
    const int g = wave >> 1, rh = wave & 1, head = hkv * 4 + g, r = lane & 31, h = lane >> 5;
    bf16x8 bqA[8], bqB[8];
    {   const bf16* q0 = QA + (size_t)(blk0 + 64 * rh + r) * D + head * 128 + 8 * h;
#pragma unroll
        for (int ks = 0; ks < 8; ++ks) bqA[ks] = *(const bf16x8*)(q0 + 16 * ks); }
    {
        v4u kv[8], vv[8];
#pragma unroll
        for (int i = 0; i < 8; ++i) { const int row = (tid >> 4) + 32 * i, ch = tid & 15; const int tok = row < 128 ? prev0 + row : blk0 + row - 128;
            kv[i] = *(const v4u*)(Kb + (size_t)tok * 512 + hkv * 128 + ch * 8); }
#pragma unroll
        for (int i = 0; i < 8; ++i) { const int row = (tid >> 4) + 32 * i, ch = tid & 15; const int tok = row < 128 ? prev0 + row : blk0 + row - 128;
            vv[i] = *(const v4u*)(Vt + (size_t)tok * 512 + hkv * 128 + ch * 8); }
        FENCE8(kv);
#pragma unroll
        for (int i = 0; i < 8; ++i) { const int row = (tid >> 4) + 32 * i, ch = tid & 15; *(LAS v4u*)(Ks + row * KRS + ch * 16) = kv[i]; }
        FENCE8(vv);
#pragma unroll
        for (int i = 0; i < 8; ++i) { const int row = (tid >> 4) + 32 * i, ch = tid & 15; *(LAS v4u*)(Vs + row * VRS + ch * 16) = vv[i]; }
    }
    const float sink2 = sinks_l[head] * LOG2E;
    FENCE8(bqA);
    __syncthreads();
#pragma unroll 1
    for (int sb = 0; sb < 2; ++sb) {
        const size_t rowoff = (size_t)(blk0 + 64 * rh + 32 * sb + r) * D + head * 128;
        attn_subblock(Ks, Vs, bqA, bqB, QA + rowoff + (size_t)32 * D + 8 * h, sb == 0, OA + rowoff, 64 * rh + 32 * sb, n, sink2, r, h);
        if (sb == 0) {
#pragma unroll
            for (int ks = 0; ks < 8; ++ks) bqA[ks] = bqB[ks]; }
    }
    __syncthreads();
}

__device__ __forceinline__ void lru_load_rows(v4u (&dst)[11], const bf16* U, int b, int s, int tq, int chan0) {
#pragma unroll
    for (int i = 0; i < 11; ++i) { const int pos = 256 * s + 8 * tq - 3 + i; v4u v; v.x = 0u; v.y = 0u; v.z = 0u; v.w = 0u;
        if (pos >= 0 && pos < SEQ) v = *(const v4u*)(U + (size_t)(b * SEQ + pos) * D + chan0);
        dst[i] = v; }
}
__device__ __forceinline__ void lru_seq(LAS unsigned char* lds, int b, int hd, int ct, const bf16* U, const bf16* LG, bf16* YL,
                                        const float* conv_w, const float* conv_b, const float* ba, const float* bx, const float* lam, const bf16* WAt, const bf16* WXt,
                                        int tid, int wave, int lane) {
    constexpr int RS = 272, TS = 80;
    LAS unsigned char* UCs = lds; LAS unsigned char* WAs = lds + 256 * RS; LAS unsigned char* WXs = WAs + 32 * RS;
    LAS float* EX = (LAS float*)(WXs + 32 * RS);
    LAS float* CW = EX + 512;
    LAS unsigned char* GLs = (LAS unsigned char*)(CW + 640);
    LAS unsigned char* YTs = GLs + 256 * TS;
    { const int row = tid >> 4, chk = tid & 15;
        *(LAS v4u*)(WAs + row * RS + chk * 16) = *(const v4u*)(WAt + (size_t)(hd * 128 + 32 * ct + row) * 128 + chk * 8);
        *(LAS v4u*)(WXs + row * RS + chk * 16) = *(const v4u*)(WXt + (size_t)(hd * 128 + 32 * ct + row) * 128 + chk * 8); }
    for (int i = tid; i < 640; i += NWAVES * 64) { const int k = i >> 7, c = i & 127; CW[i] = (k < 4) ? conv_w[k * D + hd * 128 + c] : conv_b[hd * 128 + c]; }
    const int c8 = tid & 15, tq = tid >> 4, chan0 = hd * 128 + c8 * 8;
    const int r = lane & 31, h = lane >> 5, ch = hd * 128 + 32 * ct + r;
    const float bav = ba[ch], bxv = bx[ch];
    const float sp8 = 8.0f * LOG2E * log1pf(expf(-lam[ch]));
    const int grow = tid >> 2, gq = tid & 3;
    float carry = 0.f;
    v4u raw[11], glr[2];
    lru_load_rows(raw, U, b, 0, tq, chan0);
#pragma unroll
    for (int q = 0; q < 2; ++q) glr[q] = *(const v4u*)(LG + (size_t)(b * SEQ + grow + 128 * q) * D + hd * 128 + 32 * ct + gq * 8);
    __syncthreads();
#pragma unroll 1
    for (int s = 0; s < 16; ++s) {
        {
            f32x4 cwv[5][2];
#pragma unroll
            for (int k = 0; k < 5; ++k) { cwv[k][0] = *(const LAS f32x4*)(CW + k * 128 + c8 * 8); cwv[k][1] = *(const LAS f32x4*)(CW + k * 128 + c8 * 8 + 4); }
#pragma unroll
            for (int j = 0; j < 8; ++j) {
                f32x4 o0 = cwv[4][0], o1 = cwv[4][1];
#pragma unroll
                for (int k = 0; k < 4; ++k) { const v4u v = raw[j + k];
                    o0[0] += cwv[k][0][0] * bflo(v.x); o0[1] += cwv[k][0][1] * bfhi(v.x); o0[2] += cwv[k][0][2] * bflo(v.y); o0[3] += cwv[k][0][3] * bfhi(v.y);
                    o1[0] += cwv[k][1][0] * bflo(v.z); o1[1] += cwv[k][1][1] * bfhi(v.z); o1[2] += cwv[k][1][2] * bflo(v.w); o1[3] += cwv[k][1][3] * bfhi(v.w); }
                v4u w; w.x = pk2(o0[0], o0[1]); w.y = pk2(o0[2], o0[3]); w.z = pk2(o1[0], o1[1]); w.w = pk2(o1[2], o1[3]);
                *(LAS v4u*)(UCs + (8 * tq + j) * RS + c8 * 16) = w;
            }
#pragma unroll
            for (int q = 0; q < 2; ++q) *(LAS v4u*)(GLs + (grow + 128 * q) * TS + gq * 16) = glr[q];
        }
        if (s < 15) {
            const bf16* nb = U + (size_t)(b * SEQ + 256 * (s + 1) + 8 * tq - 3) * D + chan0;
#pragma unroll
            for (int i = 0; i < 11; ++i) raw[i] = *(const v4u*)(nb + (size_t)i * D);
#pragma unroll
            for (int q = 0; q < 2; ++q) glr[q] = *(const v4u*)(LG + (size_t)(b * SEQ + 256 * (s + 1) + grow + 128 * q) * D + hd * 128 + 32 * ct + gq * 8);
        }
        __syncthreads();
        f32x16 ga, gx;
#pragma unroll
        for (int i = 0; i < 16; ++i) { ga[i] = 0.f; gx[i] = 0.f; }
        {   const LAS unsigned char* ap = UCs + (32 * wave + r) * RS + 16 * h;
            const LAS unsigned char* wap = WAs + r * RS + 16 * h;
            const LAS unsigned char* wxp = WXs + r * RS + 16 * h;
#pragma unroll
            for (int ks = 0; ks < 8; ++ks) { const bf16x8 a = *(const LAS bf16x8*)(ap + 32 * ks);
                ga = MFMA32(a, *(const LAS bf16x8*)(wap + 32 * ks), ga); gx = MFMA32(a, *(const LAS bf16x8*)(wxp + 32 * ks), gx); } }
        float P[16], Hl[16];
#pragma unroll
        for (int i = 0; i < 16; i += 2) {
            typedef float f2 __attribute__((ext_vector_type(2)));
            f2 ucv; ucv.x = bf2f(*(const LAS bf16*)(UCs + (32 * wave + crow(i, h)) * RS + (32 * ct + r) * 2)); ucv.y = bf2f(*(const LAS bf16*)(UCs + (32 * wave + crow(i + 1, h)) * RS + (32 * ct + r) * 2));
            f2 za; za.x = ga[i]; za.y = ga[i + 1]; f2 zx; zx.x = gx[i]; zx.y = gx[i + 1];
            za = (za + bav) * (-LOG2E); zx = (zx + bxv) * (-LOG2E);
            f2 ea; ea.x = __builtin_amdgcn_exp2f(za.x); ea.y = __builtin_amdgcn_exp2f(za.y);
            f2 ex; ex.x = __builtin_amdgcn_exp2f(zx.x); ex.y = __builtin_amdgcn_exp2f(zx.y);
            ea = ea + 1.0f; ex = ex + 1.0f;
            f2 rg; rg.x = __builtin_amdgcn_rcpf(ea.x); rg.y = __builtin_amdgcn_rcpf(ea.y);
            f2 ig; ig.x = __builtin_amdgcn_rcpf(ex.x); ig.y = __builtin_amdgcn_rcpf(ex.y);
            const f2 la = rg * (-sp8);
            f2 a; a.x = __builtin_amdgcn_exp2f(la.x); a.y = __builtin_amdgcn_exp2f(la.y);
            const f2 om = 1.0f - a * a;
            f2 beta; beta.x = __builtin_amdgcn_sqrtf(om.x); beta.y = __builtin_amdgcn_sqrtf(om.y);
            const f2 inp = beta * ig * ucv;
            P[i] = a.x; P[i + 1] = a.y; Hl[i] = inp.x; Hl[i + 1] = inp.y;
        }
        float Ar[4], Hr[4], ArP[4], HrP[4], cin0[4], apre[4];
#pragma unroll
        for (int g = 0; g < 4; ++g) {
#pragma unroll
            for (int e = 1; e < 4; ++e) { Hl[4 * g + e] = P[4 * g + e] * Hl[4 * g + e - 1] + Hl[4 * g + e]; P[4 * g + e] = P[4 * g + e] * P[4 * g + e - 1]; }
            Ar[g] = P[4 * g + 3]; Hr[g] = Hl[4 * g + 3];
            ArP[g] = __shfl_xor(Ar[g], 32); HrP[g] = __shfl_xor(Hr[g], 32);
        }
        float cur = 0.f, curA = 1.f;
#pragma unroll
        for (int g = 0; g < 4; ++g) {
            const float A0 = h ? ArP[g] : Ar[g], H0 = h ? HrP[g] : Hr[g], A1 = h ? Ar[g] : ArP[g], H1 = h ? Hr[g] : HrP[g];
            const float c0 = cur, p0 = curA; cur = A0 * cur + H0; curA *= A0;
            const float c1 = cur, p1 = curA; cur = A1 * cur + H1; curA *= A1;
            cin0[g] = h ? c1 : c0; apre[g] = h ? p1 : p0;
        }
        if (h == 0) { EX[wave * 64 + r] = curA; EX[wave * 64 + 32 + r] = cur; }
        __syncthreads();
        float cin = carry, mycin = 0.f;
#pragma unroll
        for (int w = 0; w < 8; ++w) { const float a = EX[w * 64 + r], hh = EX[w * 64 + 32 + r]; if (w == wave) mycin = cin; cin = a * cin + hh; }
        carry = cin;
#pragma unroll
        for (int g = 0; g < 4; ++g) {
            const float cg_ = cin0[g] + apre[g] * mycin;
#pragma unroll
            for (int e = 0; e < 4; ++e) {
                const int trow = 32 * wave + 8 * g + 4 * h + e;
                const float hv = Hl[4 * g + e] + P[4 * g + e] * cg_;
                const float gate = bf2f(*(const LAS bf16*)(GLs + trow * TS + r * 2));
                *(LAS bf16*)(YTs + trow * TS + r * 2) = (bf16)(pk2(hv * gate, 0.f) & 0xffffu);
            }
        }
        __syncthreads();
#pragma unroll
        for (int q = 0; q < 2; ++q) *(v4u*)(YL + (size_t)(b * SEQ + 256 * s + grow + 128 * q) * D + hd * 128 + 32 * ct + gq * 8) = *(const LAS v4u*)(YTs + (grow + 128 * q) * TS + gq * 16);
    }
    __syncthreads();
}

#define XB_TMO      128
#define XB_XCNT(j)  (256  + 64 * (j))
#define XB_XSUB(j)  (1280 + 64 * (j))
#define XB_XGEN(j)  (2304 + 64 * (j))
#define XB_TOP      3328
#define XB_TOPGEN   3392
#define XCD_BAR_WORDS 3456
#define XB_SPIN_CAP (1u << 21)
__device__ __forceinline__ unsigned xb_ld(unsigned* p)              { return __hip_atomic_load(p, __ATOMIC_RELAXED, __HIP_MEMORY_SCOPE_AGENT); }
__device__ __forceinline__ unsigned xb_add(unsigned* p, unsigned v) { return __hip_atomic_fetch_add(p, v, __ATOMIC_RELAXED, __HIP_MEMORY_SCOPE_AGENT); }
__device__ __forceinline__ unsigned xb_xcc_id() { return (unsigned)__builtin_amdgcn_s_getreg((3 << 11) | 20) & 0xFu; }
#define XB_SPIN(cond, bar) do { unsigned _sp = 0; while (cond) { __builtin_amdgcn_s_sleep(1); \
    if ((++_sp & 255u) == 0u) { if (xb_ld(&(bar)[XB_TMO])) break; if (_sp > XB_SPIN_CAP) { atomicAdd(&(bar)[XB_TMO], 1u); break; } } } } while (0)
struct XcdBarrier { unsigned* bar; unsigned x; volatile LAS unsigned* st; };
__device__ __forceinline__ XcdBarrier xcd_barrier_post(unsigned* bar, volatile LAS unsigned* st) {
    XcdBarrier b; b.bar = bar; b.x = xb_xcc_id(); b.st = st;
    if (threadIdx.x == 0) st[2] = xb_add(&bar[XB_XCNT(b.x)], 1u);
    return b;
}
__device__ __forceinline__ void xcd_barrier_complete(unsigned* bar, unsigned x, unsigned& nloc, unsigned& nx) {
    const unsigned G = gridDim.x * gridDim.y * gridDim.z;
    unsigned sum, cnt, mine, sp = 0u;
    for (;;) {
        sum = 0u; cnt = 0u; mine = 0u;
#pragma unroll
        for (unsigned j = 0; j < 16; ++j) { const unsigned c = xb_ld(&bar[XB_XCNT(j)]); sum += c; cnt += (c > 0u) ? 1u : 0u; mine = (j == x) ? c : mine; }
        if (sum == G) break;
        __builtin_amdgcn_s_sleep(1);
        if ((++sp & 255u) == 0u) { if (xb_ld(&bar[XB_TMO])) break; if (sp > XB_SPIN_CAP) { atomicAdd(&bar[XB_TMO], 1u); break; } }
    }
    nloc = mine > 0u ? mine : 1u; nx = cnt > 0u ? cnt : 1u;
}
__device__ __forceinline__ void xcd_barrier(const XcdBarrier& b) {
    asm volatile("s_waitcnt vmcnt(0)" ::: "memory");
    __syncthreads();
    if (threadIdx.x == 0) {
        unsigned* bar = b.bar;
        __builtin_amdgcn_s_waitcnt(0);
        unsigned nloc = b.st[0], nx = b.st[1];
        if (nloc == 0u) { xcd_barrier_complete(bar, b.x, nloc, nx); b.st[0] = nloc; b.st[1] = nx; }
        const unsigned old = xb_add(&bar[XB_XSUB(b.x)], 1u);
        const unsigned gen = old / nloc;
        if (old + 1u == (gen + 1u) * nloc) {
            __builtin_amdgcn_fence(__ATOMIC_RELEASE, "agent");
            asm volatile("s_waitcnt vmcnt(0)" ::: "memory");
            const unsigned og = xb_add(&bar[XB_TOP], 1u);
            const unsigned tg = og / nx;
            if (og + 1u == (tg + 1u) * nx) xb_add(&bar[XB_TOPGEN], 1u);
            else XB_SPIN(xb_ld(&bar[XB_TOPGEN]) == tg, bar);
            __builtin_amdgcn_fence(__ATOMIC_ACQUIRE, "agent");
            xb_add(&bar[XB_XGEN(b.x)], 1u);
            asm volatile("s_waitcnt vmcnt(0)" ::: "memory");
        } else {
            XB_SPIN(xb_ld(&bar[XB_XGEN(b.x)]) == gen, bar);
            __builtin_amdgcn_fence(__ATOMIC_ACQUIRE, "agent");
            asm volatile("s_waitcnt vmcnt(0)" ::: "memory");
        }
    }
    __syncthreads();
}

struct Args { const float* in[22]; float* out; unsigned char* ws; };
enum { I_X = 0, I_C, I_ADAW, I_ADAB, I_N1G, I_WIN, I_BIN, I_CONVW, I_CONVB, I_WA, I_BA, I_WX, I_BX, I_LAM, I_SINKS, I_WLO, I_WAO, I_WO, I_N2G, I_WFI, I_WFO, I_FG };

__global__ void __launch_bounds__(NWAVES * 64, 2) mk_fwd(Args args) {
    extern __shared__ __attribute__((aligned(16))) unsigned char lds_raw[];
    cg::grid_group grid = cg::this_grid();
    LAS unsigned char* lds = (LAS unsigned char*)lds_raw;
#define GSYNC() xcd_barrier(xbar)
#define FRESH_TID() int tid_f = threadIdx.x; asm volatile("" : "+v"(tid_f)); const int tid = tid_f, lane = tid_f & 63; (void)tid; (void)lane
    const int wave = __builtin_amdgcn_readfirstlane((int)threadIdx.x >> 6);
    const int G = gridDim.x, bx = blockIdx.x;
    const int vcu = (G % 8 == 0) ? (bx % 8) * (G / 8) + bx / 8 : bx;
    const int gw = vcu * NWAVES + wave, NGW = G * NWAVES;
    unsigned char* ws = args.ws;
    volatile LAS unsigned* xst = (volatile LAS unsigned*)(lds + LDS_BYTES - 64);
    if (threadIdx.x == 0) { xst[0] = 0u; xst[1] = 0u; xst[2] = 0u; xst[3] = 0u; }
    __syncthreads();
    const XcdBarrier xbar = xcd_barrier_post((unsigned*)(ws + WS_BAR), xst);
    float* MODP = (float*)(ws + WS_MODP); float* MOD = (float*)(ws + WS_MOD);
    bf16* Hb = (bf16*)(ws + WS_H); bf16* Ub = (bf16*)(ws + WS_U); bf16* LGb = (bf16*)(ws + WS_LG); bf16* Qb = (bf16*)(ws + WS_Q);
    bf16* Kbuf = (bf16*)(ws + WS_K); bf16* Vtb = (bf16*)(ws + WS_VT); bf16* MGb = (bf16*)(ws + WS_MG); bf16* HIDb = (bf16*)(ws + WS_HID);
    float* xout = args.out; bf16* XB = (bf16*)(ws + WS_XB);

    {
        FRESH_TID();
        LAS float* scr = (LAS float*)(lds + wave * 16384);
        for (int it = gw; it < 2 * 48 * 16; it += NGW) {
            const int ks = it & 15, nb = (it >> 4) % 48, l = it / (16 * 48);
            const float* cp = args.in[I_C];
            float sv[4][2];
#pragma unroll
            for (int b = 0; b < 4; ++b)
#pragma unroll
                for (int q = 0; q < 2; ++q) { const float c = cp[b * D + ks * 128 + q * 64 + lane]; sv[b][q] = c * sigmoid_f(c); }
            const float* wp = args.in[I_ADAW] + ((size_t)l * D + ks * 128) * (NMOD * D) + nb * 256 + lane * 4;
            f32x4 acc[4];
#pragma unroll
            for (int b = 0; b < 4; ++b) acc[b] = (f32x4){0.f, 0.f, 0.f, 0.f};
#pragma unroll
            for (int q = 0; q < 2; ++q)
#pragma unroll 8
                for (int kk = 0; kk < 64; ++kk) {
                    const f32x4 w = *(const f32x4*)(wp + (size_t)(q * 64 + kk) * (NMOD * D));
#pragma unroll
                    for (int b = 0; b < 4; ++b) acc[b] += w * __shfl(sv[b][q], kk);
                }
#pragma unroll
            for (int b = 0; b < 4; ++b) *(f32x4*)(MODP + ((size_t)((l * 16 + ks) * 4 + b)) * (NMOD * D) + nb * 256 + lane * 4) = acc[b];
        }
        constexpr int I_IN = 32 * (CIN / 32), I_SQ = 32 * (D / 32), I_FO = (FFN / 64) * (D / 32), I_LR = 16 * 2 * 4;
        constexpr int PER_L = 2 * I_IN + 3 * I_SQ + I_FO + 2 * I_LR;
        for (int it = gw; it < 2 * PER_L; it += NGW) {
            const int l = it / PER_L; int rr = it % PER_L;
            unsigned char* wl = ws + WS_W + (size_t)l * W_LAYER;
            if (rr < I_IN) { transpose_mat(args.in[I_WIN] + (size_t)l * D * CIN, D, CIN, (bf16*)(wl + WO_IN), rr, scr, lane, 2); continue; } rr -= I_IN;
            if (rr < I_IN) { transpose_mat(args.in[I_WFI] + (size_t)l * D * CIN, D, CIN, (bf16*)(wl + WO_FI), rr, scr, lane, 1); continue; } rr -= I_IN;
            if (rr < I_SQ) { transpose_mat(args.in[I_WLO] + (size_t)l * D * D, D, D, (bf16*)(wl + WO_LO), rr, scr, lane, 0); continue; } rr -= I_SQ;
            if (rr < I_SQ) { transpose_mat(args.in[I_WAO] + (size_t)l * D * D, D, D, (bf16*)(wl + WO_AO), rr, scr, lane, 0); continue; } rr -= I_SQ;
            if (rr < I_SQ) { transpose_mat(args.in[I_WO] + (size_t)l * D * D, D, D, (bf16*)(wl + WO_O), rr, scr, lane, 0); continue; } rr -= I_SQ;
            if (rr < I_FO) { transpose_mat(args.in[I_WFO] + (size_t)l * FFN * D, FFN, D, (bf16*)(wl + WO_FO), rr, scr, lane, 0); continue; } rr -= I_FO;
            {
                const bool second = rr >= I_LR; if (second) rr -= I_LR;
                const int hd = rr >> 3, sub = rr & 7;
                const float* src = args.in[second ? I_WX : I_WA] + ((size_t)l * 16 + hd) * 128 * 128;
                bf16* dst = (bf16*)(wl + (second ? WO_WX : WO_WA)) + (size_t)hd * 128 * 128;
                transpose_mat(src, 128, 128, dst, sub, scr, lane, 0);
            }
        }
    }
    GSYNC();
    if (args.ws == nullptr) grid.sync();
    int vb = bx;
    {   if (threadIdx.x == 0) { unsigned* bar = (unsigned*)(ws + WS_BAR); bool ok = (G % 8 == 0);
            for (unsigned j = 0; j < 16; ++j) { const unsigned c = xb_ld(&bar[XB_XCNT(j)]); ok = ok && (c == (j < 8 ? (unsigned)(G / 8) : 0u)); }
            xst[3] = ok ? (xbar.x + 8u * xst[2]) : (unsigned)bx; }
        __syncthreads();
        vb = __builtin_amdgcn_readfirstlane((int)xst[3]); }
    const int vgw = ((G % 8 == 0) ? (vb % 8) * (G / 8) + vb / 8 : vb) * NWAVES + wave;
    { FRESH_TID();
    for (int i = bx * (NWAVES * 64) + tid; i < 2 * 4 * NMOD * D; i += G * NWAVES * 64) {
        const int n = i % (NMOD * D), lb = i / (NMOD * D), l = lb >> 2, b = lb & 3;
        float s = args.in[I_ADAB][l * NMOD * D + n];
#pragma unroll
        for (int ks = 0; ks < 16; ++ks) s += MODP[((size_t)((l * 16 + ks) * 4 + b)) * (NMOD * D) + n];
        MOD[i] = s;
    } }
    GSYNC();

#pragma unroll 1
    for (int l = 0; l < DEPTH; ++l) {
        const float* modl = MOD + (size_t)l * 4 * NMOD * D;
        unsigned char* wl = ws + WS_W + (size_t)l * W_LAYER;
        { FRESH_TID();
        for (int m = vgw; m < M; m += NGW) { const float* mb = modl + (m >> 12) * (NMOD * D);
            if (l == 0) norm_row_bf16(args.in[I_X] + (size_t)m * D, Hb + (size_t)m * D, args.in[I_N1G] + l * D, mb, mb + D, lane);
            else norm_row_bf16in(XB + (size_t)m * D, Hb + (size_t)m * D, args.in[I_N1G] + l * D, mb, mb + D, lane); } }
        GSYNC();
        {   pg8::Gemm g{Hb, (const bf16*)(wl + WO_IN), M, CIN, D}; pg8::StaticOrder S; S.init(M, CIN, G, vb);
            EpiIn E{args.in[I_BIN] + (size_t)l * CIN, Ub, LGb, Qb, Kbuf, Vtb, MGb};
            pg8::gemm_phase<EpiIn, pg8::StaticOrder, true, true>(lds, g, S, E); }
        GSYNC();
        {
            FRESH_TID();
            for (int u = vb; u < 4 * 16 * 4; u += G) {
                const int xc = u & 7, rk = u >> 3, ct = rk & 3, bh = xc + 8 * (rk >> 2), hd = bh & 15, b = bh >> 4;
                lru_seq(lds, b, hd, ct, Ub, LGb, Hb, args.in[I_CONVW] + (size_t)l * 4 * D, args.in[I_CONVB] + l * D, args.in[I_BA] + l * D, args.in[I_BX] + l * D,
                        args.in[I_LAM] + l * D, (const bf16*)(wl + WO_WA), (const bf16*)(wl + WO_WX), tid, wave, lane); }
            for (int u = vb; u < 4 * 32 * 4; u += G) { const int hkv = u & 3, n = (u >> 2) & 31, b = u >> 7;
                attn_unit(lds, b, n, hkv, Qb, Qb, Kbuf, Vtb, args.in[I_SINKS] + l * 16, tid, wave, lane); }
        }
        GSYNC();
        {   pg8::Gemm g{Hb, (const bf16*)(wl + WO_LO), M, D, D, Qb, (const bf16*)(wl + WO_AO)}; pg8::StaticOrder S; S.init(M, D, G, vb);
            EpiMerge E{MGb, Ub};
            pg8::gemm_phase<EpiMerge, pg8::StaticOrder, true, true>(lds, g, S, E); }
        GSYNC();
        {   pg8::Gemm g{Ub, (const bf16*)(wl + WO_O), M, D, D}; pg8::StaticOrder S; S.init(M, D, G, vb);
            EpiRes E{(l == 0) ? (const void*)args.in[I_X] : (const void*)XB, XB, modl + 2 * D, (l == 0) ? 1 : 0};
            pg8::gemm_phase<EpiRes, pg8::StaticOrder, true, true>(lds, g, S, E); }
        GSYNC();
        { FRESH_TID();
        for (int m = vgw; m < M; m += NGW) { const float* mb = modl + (m >> 12) * (NMOD * D);
            norm_row_bf16in(XB + (size_t)m * D, Hb + (size_t)m * D, args.in[I_N2G] + l * D, mb + 3 * D, mb + 4 * D, lane); } }
        GSYNC();
        {   pg8::Gemm g{Hb, (const bf16*)(wl + WO_FI), M, CIN, D}; pg8::StaticOrder S; S.init(M, CIN, G, vb);
            EpiSwiglu E{HIDb};
            pg8::gemm_phase<EpiSwiglu, pg8::StaticOrder, true, true>(lds, g, S, E); }
        GSYNC();
        {   pg8::Gemm g{HIDb, (const bf16*)(wl + WO_FO), M, D, FFN}; pg8::StaticOrder S; S.init(M, D, G, vb);
            EpiRes E{(const void*)XB, XB, modl + 5 * D, 0};
            pg8::gemm_phase<EpiRes, pg8::StaticOrder, true, true>(lds, g, S, E); }
        GSYNC();
    }
    FRESH_TID();
    for (int m = vgw; m < M; m += NGW) final_norm_row(XB + (size_t)m * D, xout + (size_t)m * D, args.in[I_FG], lane);
}

extern "C" void kernel_launch(void* const* d_in, const int* in_sizes, int n_in, void* d_out, int out_size, void* d_ws, size_t ws_size, hipStream_t stream) {
    static int grid = 0;
    if (grid == 0) {
        if (n_in != 22 || in_sizes[0] != M * D || out_size != M * D || ws_size < WS_END) { fprintf(stderr, "kernel_launch: unexpected shapes (n_in %d, in0 %d, out %d, ws %zu); nothing launched\n", n_in, n_in > 0 ? in_sizes[0] : -1, out_size, ws_size); grid = -1; return; }
        int dev = 0, cus = 0, per_cu = 0;
        if (hipGetDevice(&dev) != hipSuccess || hipDeviceGetAttribute(&cus, hipDeviceAttributeMultiprocessorCount, dev) != hipSuccess) { grid = -1; return; }
        if (hipFuncSetAttribute((const void*)mk_fwd, hipFuncAttributeMaxDynamicSharedMemorySize, LDS_BYTES) != hipSuccess) { fprintf(stderr, "kernel_launch: hipFuncSetAttribute failed\n"); grid = -1; return; }
        if (hipOccupancyMaxActiveBlocksPerMultiprocessor(&per_cu, (const void*)mk_fwd, NWAVES * 64, LDS_BYTES) != hipSuccess || per_cu < 1) { fprintf(stderr, "kernel_launch: occupancy query gave %d\n", per_cu); per_cu = 1; }
        (void)hipGetLastError();
        grid = cus * per_cu;
    }
    if (grid < 0) return;
    Args a{};
    for (int i = 0; i < 22; ++i) a.in[i] = (const float*)d_in[i];
    a.out = (float*)d_out; a.ws = (unsigned char*)d_ws;
    if (hipMemsetAsync((char*)d_ws + WS_BAR, 0, BAR_ZERO_BYTES, stream) != hipSuccess) { fprintf(stderr, "kernel_launch: memset failed\n"); return; }
    void* kargs[] = {&a};
    hipError_t e = hipLaunchCooperativeKernel((const void*)mk_fwd, dim3(grid), dim3(NWAVES * 64), kargs, LDS_BYTES, stream);
    if (e != hipSuccess) fprintf(stderr, "kernel_launch: cooperative launch failed: %s (grid %d)\n", hipGetErrorString(e), grid);
}
```

```cpp
#include <hip/hip_runtime.h>
#include <hip/hip_cooperative_groups.h>
#include <cstdio>
#include <cstdint>
namespace cg = cooperative_groups;
namespace pg8 {
#define PG8_LAS __attribute__((address_space(3)))
typedef unsigned short bf16_t;
typedef short bf16x8 __attribute__((ext_vector_type(8)));
typedef float f32x4 __attribute__((ext_vector_type(4)));
typedef unsigned u32x4 __attribute__((ext_vector_type(4)));
constexpr int BM = 256, BK = 64, HALF = 128, HTB = HALF * BK * 2  , STAGE_BYTES = 8 * HTB, NXCD = 8, WGM = 8;

__host__ __device__ __forceinline__ int lds_byte(int r, int c) { const int st = (r >> 4) * 2 + (c >> 5), rr = r & 15, cc = c & 31, ob = rr * 64 + cc * 2; return st * 1024 + (ob ^ (((ob >> 9) & 1) << 5)); }
__host__ __device__ __forceinline__ void stage_rc(int b, int& R, int& C) { const int st = b / 1024, sb = b % 1024, swz = sb ^ (((sb >> 9) & 1) << 5); R = (st >> 1) * 16 + swz / 64; C = (st & 1) * 32 + (swz % 64) / 2; }
__host__ __device__ __forceinline__ int perm32(int rho) { const int n = rho >> 4, i = rho & 15; return 8 * (i >> 2) + 4 * n + (i & 3); }

struct Unit { int pm, pn; };
struct Gemm { const bf16_t* A; const bf16_t* Bt; int M, N, K; const bf16_t* A2 = nullptr; const bf16_t* Bt2 = nullptr; };

struct StaticOrder {
    int nM, nN, nwg, G, c;
    __host__ __device__ void init(int M, int N, int G_, int c_) { nM = M / BM; nN = N / BM; nwg = nM * nN; G = G_; c = c_; }
    __host__ __device__ bool next(int i, Unit& u) const {
        const long L = (long)i * G + c; if (L >= nwg) return false;
        int wgid = (int)L; { const int q = nwg / NXCD, r = nwg % NXCD, xcd = wgid % NXCD, off = wgid / NXCD; wgid = (xcd < r ? xcd * (q + 1) : r * (q + 1) + (xcd - r) * q) + off; }
        const int nig = WGM * nN, gid = wgid / nig, fm = gid * WGM, gsz = (nM - fm) < WGM ? (nM - fm) : WGM;
        u.pm = fm + ((wgid % nig) % gsz); u.pn = (wgid % nig) / gsz; return true;
    }
    __device__ __forceinline__ void a_ready(const Unit&) const {}
    __device__ __forceinline__ void done(const Unit&) const {}
};
__device__ __forceinline__ unsigned cvt_pk_bf16(float lo, float hi) { unsigned r; asm volatile("v_cvt_pk_bf16_f32 %0, %1, %2" : "=v"(r) : "v"(lo), "v"(hi)); return r; }
typedef float f32x2 __attribute__((ext_vector_type(2)));
template <class Epi, class Sched, bool ALIGN_EPI = false, bool SP2 = false>
__device__ __forceinline__ void gemm_phase(PG8_LAS unsigned char* lds, const Gemm g, const Sched& S, const Epi& E) {
    int tid_ = threadIdx.x; asm volatile("" : "+v"(tid_));
    const int tid = tid_, wid = __builtin_amdgcn_readfirstlane(tid >> 6), lane = tid & 63, wr = wid >> 2, wc = wid & 3, fr = lane & 15, fq = lane >> 4;
    const int K = g.K, nt1 = K / BK, nt = Epi::DUAL ? 2 * nt1 : nt1;
    unsigned voffA[2], voffB[2];
#pragma unroll
    for (int i = 0; i < 2; ++i) { int R, C; stage_rc(tid * 16 + i * 8192, R, C); const int Rb = Epi::PERM ? ((R & ~31) + perm32(R & 31)) : R;
        voffA[i] = (unsigned)(R * K + C) * 2u; voffB[i] = (unsigned)(Rb * K + C) * 2u; }
    const size_t kstep = (size_t)(BK * 2);
    const size_t hstep = (size_t)HALF * K * 2;
    const size_t tstep = 2 * hstep;
    const unsigned ldsw = (unsigned)wid * 1024u;
    const int aoff = lds_byte(wr * 64 + fr, fq * 8), boff = lds_byte(wc * 32 + fr, fq * 8);
#define PG8_SA(b, h) (((b) * 2 + (h)) * HTB)
#define PG8_SB(b, h) ((4 + (b) * 2 + (h)) * HTB)
#define PG8_STAGE(bufoff, gbase, voff) do { _Pragma("unroll") for (int _i = 0; _i < 2; ++_i) \
        __builtin_amdgcn_global_load_lds((const unsigned*)((const char*)(gbase) + (voff)[_i]), (PG8_LAS unsigned*)(lds + (bufoff) + ldsw + _i * 8192), 16, 0, 0); } while (0)
#define PG8_LDA(dst, b, h) do { _Pragma("unroll") for (int m = 0; m < 4; ++m) _Pragma("unroll") for (int k = 0; k < 2; ++k) dst[m][k] = *(const PG8_LAS bf16x8*)(lds + PG8_SA(b, h) + aoff + m * 2048 + k * 1024); } while (0)
#define PG8_LDB(dst, b, h) do { _Pragma("unroll") for (int n = 0; n < 2; ++n) _Pragma("unroll") for (int k = 0; k < 2; ++k) dst[n][k] = *(const PG8_LAS bf16x8*)(lds + PG8_SB(b, h) + boff + n * 2048 + k * 1024); } while (0)
#define PG8_MMA(ai, bj, At, Bt) do { __builtin_amdgcn_s_setprio(1); _Pragma("unroll") for (int m = 0; m < 4; ++m) _Pragma("unroll") for (int n = 0; n < 2; ++n) _Pragma("unroll") for (int k = 0; k < 2; ++k) \
        acc[ai][bj][m][n] = __builtin_amdgcn_mfma_f32_16x16x32_bf16(Bt[n][k], At[m][k], acc[ai][bj][m][n], 0, 0, 0); __builtin_amdgcn_s_setprio(0); } while (0)
#define PG8_WAIT_V(n) asm volatile("s_waitcnt vmcnt(" #n ")" ::: "memory")
#define PG8_WAIT_L(n) asm volatile("s_waitcnt lgkmcnt(" #n ")" ::: "memory")
#define PG8_BAR __builtin_amdgcn_s_barrier()
#define PG8_SCHED __builtin_amdgcn_sched_barrier(0)
    Unit cur, nxt; int ui = 0;
    if (!S.next(0, cur)) return;
    f32x4 acc[2][2][4][2];
#pragma unroll
    for (int a = 0; a < 2; ++a)
#pragma unroll
        for (int b = 0; b < 2; ++b)
#pragma unroll
            for (int m = 0; m < 4; ++m)
#pragma unroll
                for (int n = 0; n < 2; ++n) acc[a][b][m][n] = (f32x4){0.f, 0.f, 0.f, 0.f};
    bf16x8 At[4][2], B0[2][2], B1[2][2];
    const char* cA = (const char*)g.A + (size_t)cur.pm * tstep; const char* cB = (const char*)g.Bt + (size_t)cur.pn * tstep;
    const char* cA2 = Epi::DUAL ? (const char*)g.A2 + (size_t)cur.pm * tstep : cA; const char* cB2 = Epi::DUAL ? (const char*)g.Bt2 + (size_t)cur.pn * tstep : cB;
    S.a_ready(cur);
    if constexpr (SP2) {
        PG8_STAGE(PG8_SB(0, 0), cB, voffB); PG8_STAGE(PG8_SB(0, 1), cB + hstep, voffB); PG8_STAGE(PG8_SA(0, 0), cA, voffA); PG8_STAGE(PG8_SA(0, 1), cA + hstep, voffA);
        if (wr == 1) PG8_BAR;
        PG8_WAIT_V(2); PG8_BAR;
        PG8_STAGE(PG8_SB(1, 0), cB + kstep, voffB); PG8_STAGE(PG8_SA(1, 0), cA + kstep, voffA); PG8_STAGE(PG8_SB(1, 1), cB + hstep + kstep, voffB);
        PG8_WAIT_V(6); PG8_BAR;
    } else {
        PG8_STAGE(PG8_SB(0, 0), cB, voffB); PG8_STAGE(PG8_SA(0, 0), cA, voffA); PG8_STAGE(PG8_SB(0, 1), cB + hstep, voffB); PG8_STAGE(PG8_SA(0, 1), cA + hstep, voffA);
        if (wr == 1) PG8_BAR;
        PG8_WAIT_V(4); PG8_BAR;
        PG8_STAGE(PG8_SB(1, 0), cB + kstep, voffB); PG8_STAGE(PG8_SA(1, 0), cA + kstep, voffA); PG8_STAGE(PG8_SB(1, 1), cB + hstep + kstep, voffB);
        PG8_WAIT_V(6); PG8_BAR;
    }
    for (;;) {
        const bool has_next = S.next(ui + 1, nxt);
        const char* nA = has_next ? (const char*)g.A + (size_t)nxt.pm * tstep : cA; const char* nB = has_next ? (const char*)g.Bt + (size_t)nxt.pn * tstep : cB;
        for (int t = 0; t < nt; t += 2) {
            const bool last = (t == nt - 2);
            const char* tA1 = cA + (size_t)(t + 1) * kstep; const char* tA2 = cA + (size_t)(t + 2) * kstep; const char* tB2 = cB + (size_t)(t + 2) * kstep;
            if constexpr (Epi::DUAL) {
                if (t >= nt1) tA1 = cA2 + (size_t)(t + 1 - nt1) * kstep;
                if (t + 2 >= nt1) { tA2 = cA2 + (size_t)(t + 2 - nt1) * kstep; tB2 = cB2 + (size_t)(t + 2 - nt1) * kstep; }
                if (t == nt1) { int fr_m = fr, fq_m = fq; asm volatile("" : "+v"(fr_m), "+v"(fq_m)); E.mid(acc, cur, wr, wc, fr_m, fq_m); }
            }
            const char* a1 = tA1;
            const char* a2 = last ? nA : tA2; const char* b2 = last ? nB : tB2;
            const char* a3 = a2 + kstep; const char* b3 = b2 + kstep;
            if (last && has_next) S.a_ready(nxt);
            if constexpr (SP2) {
            PG8_LDB(B0, 0, 0); PG8_LDB(B1, 0, 1); PG8_SCHED; PG8_LDA(At, 0, 0); PG8_STAGE(PG8_SA(1, 1), a1 + hstep, voffA);
            PG8_WAIT_V(8); PG8_WAIT_L(0); PG8_BAR; PG8_MMA(0, 0, At, B0); PG8_MMA(0, 1, At, B1); PG8_BAR; PG8_SCHED;
            PG8_LDA(At, 0, 1); PG8_STAGE(PG8_SB(0, 0), b2, voffB); PG8_STAGE(PG8_SB(0, 1), b2 + hstep, voffB); PG8_STAGE(PG8_SA(0, 0), a2, voffA);
            PG8_WAIT_V(8); PG8_WAIT_L(0); PG8_BAR; PG8_MMA(1, 0, At, B0); PG8_MMA(1, 1, At, B1); PG8_BAR; PG8_SCHED;
            PG8_LDB(B0, 1, 0); PG8_LDB(B1, 1, 1); PG8_SCHED; PG8_LDA(At, 1, 0); PG8_STAGE(PG8_SA(0, 1), a2 + hstep, voffA);
            PG8_WAIT_V(8); PG8_WAIT_L(0); PG8_BAR; PG8_MMA(0, 0, At, B0); PG8_MMA(0, 1, At, B1); PG8_BAR; PG8_SCHED;
            PG8_LDA(At, 1, 1); PG8_STAGE(PG8_SB(1, 0), b3, voffB); PG8_STAGE(PG8_SB(1, 1), b3 + hstep, voffB); PG8_STAGE(PG8_SA(1, 0), a3, voffA);
            PG8_WAIT_V(8); PG8_WAIT_L(0); PG8_BAR; PG8_MMA(1, 0, At, B0); PG8_MMA(1, 1, At, B1); PG8_BAR; PG8_SCHED;
            } else {
            PG8_LDB(B0, 0, 0); PG8_SCHED; PG8_LDA(At, 0, 0); PG8_STAGE(PG8_SA(1, 1), a1 + hstep, voffA);
            PG8_WAIT_L(8); PG8_BAR; PG8_WAIT_L(0); PG8_MMA(0, 0, At, B0); PG8_BAR; PG8_SCHED;
            PG8_LDB(B1, 0, 1); PG8_STAGE(PG8_SB(0, 0), b2, voffB);
            PG8_BAR; PG8_WAIT_L(0); PG8_MMA(0, 1, At, B1); PG8_BAR;
            PG8_LDA(At, 0, 1); PG8_STAGE(PG8_SA(0, 0), a2, voffA);
            PG8_BAR; PG8_WAIT_L(0); PG8_MMA(1, 0, At, B0); PG8_BAR; PG8_SCHED;
            PG8_STAGE(PG8_SB(0, 1), b2 + hstep, voffB);
            PG8_WAIT_V(6); PG8_BAR; PG8_MMA(1, 1, At, B1); PG8_BAR;
            PG8_LDB(B0, 1, 0); PG8_SCHED; PG8_LDA(At, 1, 0); PG8_STAGE(PG8_SA(0, 1), a2 + hstep, voffA);
            PG8_WAIT_L(8); PG8_BAR; PG8_WAIT_L(0); PG8_MMA(0, 0, At, B0); PG8_BAR; PG8_SCHED;
            PG8_LDB(B1, 1, 1); PG8_STAGE(PG8_SB(1, 0), b3, voffB);
            PG8_BAR; PG8_WAIT_L(0); PG8_MMA(0, 1, At, B1); PG8_BAR;
            PG8_LDA(At, 1, 1); PG8_STAGE(PG8_SA(1, 0), a3, voffA);
            PG8_BAR; PG8_WAIT_L(0); PG8_MMA(1, 0, At, B0); PG8_BAR; PG8_SCHED;
            PG8_STAGE(PG8_SB(1, 1), b3 + hstep, voffB);
            PG8_WAIT_V(6); PG8_BAR; PG8_MMA(1, 1, At, B1); PG8_BAR;
            }
        }
        if constexpr (ALIGN_EPI) { if (wr == 0) PG8_BAR; }
        if constexpr (!Epi::AFTER_DRAIN) { int fr_e = fr, fq_e = fq; asm volatile("" : "+v"(fr_e), "+v"(fq_e)); E(acc, cur, wr, wc, fr_e, fq_e); S.done(cur); }
        if (!has_next) break;
#pragma unroll
        for (int a = 0; a < 2; ++a)
#pragma unroll
            for (int b = 0; b < 2; ++b)
#pragma unroll
                for (int m = 0; m < 4; ++m)
#pragma unroll
                    for (int n = 0; n < 2; ++n) acc[a][b][m][n] = (f32x4){0.f, 0.f, 0.f, 0.f};
        cur = nxt; cA = nA; cB = nB; ++ui;
        if constexpr (Epi::DUAL) { cA2 = (const char*)g.A2 + (size_t)cur.pm * tstep; cB2 = (const char*)g.Bt2 + (size_t)cur.pn * tstep; }
        if constexpr (ALIGN_EPI) { if (wr == 1) PG8_BAR; }
    }
    PG8_WAIT_V(0);
    if constexpr (!ALIGN_EPI) { if (wr == 0) PG8_BAR; }
    PG8_BAR;
    if constexpr (Epi::AFTER_DRAIN) { E.fused(acc, cur, wr, wc, fr, fq, lds, wid, lane); S.done(cur); }
#undef PG8_SA
#undef PG8_SB
#undef PG8_STAGE
#undef PG8_LDA
#undef PG8_LDB
#undef PG8_MMA
#undef PG8_WAIT_V
#undef PG8_WAIT_L
#undef PG8_BAR
#undef PG8_SCHED
}
}

constexpr int NWAVES = 8;
constexpr int D = 2048, SEQ = 4096, NB = 4, M = NB * SEQ, CIN = 11264, FFN = 5632, NMOD = 6, DEPTH = 2;
constexpr float EPS = 1e-6f, LOG2E = 1.4426950408889634f;
constexpr float SC2 = 0.08838834764831845f * 1.4426950408889634f;

constexpr size_t MiB = 1u << 20;
constexpr size_t WS_BAR = 0, BAR_ZERO_BYTES = 16384;
constexpr size_t WS_MODP = 2 * MiB;
constexpr size_t WS_MOD = 9 * MiB;
constexpr size_t WS_W = 16 * MiB, W_LAYER = 135 * MiB;
constexpr size_t WO_IN = 0, WO_LO = 44 * MiB, WO_AO = 52 * MiB, WO_O = 60 * MiB, WO_FI = 68 * MiB, WO_FO = 112 * MiB, WO_WA = 134 * MiB, WO_WX = 134 * MiB + 512 * 1024;
constexpr size_t WS_H = 288 * MiB;
constexpr size_t WS_U = 352 * MiB, WS_LG = 416 * MiB, WS_Q = 480 * MiB, WS_K = 544 * MiB, WS_VT = 560 * MiB, WS_MG = 576 * MiB;
constexpr size_t WS_HID = 352 * MiB;
constexpr size_t WS_XB = 704 * MiB;
constexpr size_t WS_END = 768 * MiB;
constexpr int LDS_BYTES = 155648;

#define GAS __attribute__((address_space(1)))
#define LAS __attribute__((address_space(3)))
typedef unsigned short bf16;
typedef unsigned v4u __attribute__((ext_vector_type(4)));
typedef unsigned v2u __attribute__((ext_vector_type(2)));
typedef float f32x4 __attribute__((ext_vector_type(4)));
typedef float f32x16 __attribute__((ext_vector_type(16)));
typedef short bf16x8 __attribute__((ext_vector_type(8)));
typedef short s16x4 __attribute__((ext_vector_type(4)));
typedef short v4i16_t __attribute__((ext_vector_type(4)));
typedef __bf16 bf16x2_t __attribute__((ext_vector_type(2)));
typedef float f32x2_t __attribute__((ext_vector_type(2)));
#define LDS_WAIT() asm volatile("s_waitcnt lgkmcnt(0)" ::: "memory")

__device__ __forceinline__ unsigned pk2(float lo, float hi) { f32x2_t v = {lo, hi}; bf16x2_t b = __builtin_convertvector(v, bf16x2_t); return __builtin_bit_cast(unsigned, b); }
__device__ __forceinline__ float bflo(unsigned w) { return __builtin_bit_cast(float, w << 16); }
__device__ __forceinline__ float bfhi(unsigned w) { return __builtin_bit_cast(float, w & 0xffff0000u); }
__device__ __forceinline__ float bf2f(bf16 b) { return __builtin_bit_cast(float, ((unsigned)b) << 16); }
__device__ __forceinline__ float sigmoid_f(float v) { return __builtin_amdgcn_rcpf(1.0f + __builtin_amdgcn_exp2f(-v * LOG2E)); }
__device__ __forceinline__ float gelu_tanh_f(float v) { const float z = 1.5957691216057308f * (v + 0.044715f * v * v * v); return v * sigmoid_f(z); }
__device__ __forceinline__ float wave_sum(float v) {
#pragma unroll
    for (int o = 1; o < 64; o <<= 1) v += __shfl_xor(v, o);
    return v;
}

using pg8::Unit; using pg8::bf16_t;
struct EpiIn {
    static constexpr bool PERM = true, AFTER_DRAIN = false, DUAL = false;
    const float* bias; bf16* U; bf16* LG; bf16* Q; bf16* Kb; bf16* Vt; bf16* MG;
    template <int MODE> __device__ __forceinline__ void body(const f32x4 (&acc)[2][2][4][2], bf16* base, int ldc, int c0, int row0, int lc, const f32x4 (&bv)[2][2]) const {
#pragma unroll
        for (int ai = 0; ai < 2; ++ai)
#pragma unroll
            for (int m = 0; m < 4; ++m) {
                const int row = row0 + ai * 128 + m * 16;
#pragma unroll
                for (int bj = 0; bj < 2; ++bj) {
                    f32x4 v0 = acc[ai][bj][m][0] + bv[bj][0], v1 = acc[ai][bj][m][1] + bv[bj][1];
                    if (MODE == 1) {
#pragma unroll
                        for (int j = 0; j < 4; ++j) { v0[j] = gelu_tanh_f(v0[j]); v1[j] = gelu_tanh_f(v1[j]); }
                    } else if (MODE == 2) {
#pragma unroll
                        for (int j = 0; j < 4; ++j) { v0[j] = sigmoid_f(v0[j]); v1[j] = sigmoid_f(v1[j]); }
                    }
                    v4u w; w.x = pk2(v0[0], v0[1]); w.y = pk2(v0[2], v0[3]); w.z = pk2(v1[0], v1[1]); w.w = pk2(v1[2], v1[3]);
                    if (MODE != 3) {
                        *(v4u*)(base + (size_t)row * ldc + c0 + bj * 128 + lc) = w;
                    } else {
                        const int b = row >> 12, s = row & 4095, cv = c0 + bj * 128 + lc;
                        bf16* p = base + (((size_t)(b * 512 + cv)) << 12) + s;
                        p[0 << 12] = (bf16)(w.x & 0xffffu); p[1 << 12] = (bf16)(w.x >> 16);
                        p[2 << 12] = (bf16)(w.y & 0xffffu); p[3 << 12] = (bf16)(w.y >> 16);
                        p[4 << 12] = (bf16)(w.z & 0xffffu); p[5 << 12] = (bf16)(w.z >> 16);
                        p[6 << 12] = (bf16)(w.w & 0xffffu); p[7 << 12] = (bf16)(w.w >> 16);
                    }
                }
            }
    }
    __device__ __forceinline__ void body_mix(const f32x4 (&acc)[2][2][4][2], int t, int row0, int lc, const f32x4 (&bv)[2][2]) const {
#pragma unroll
        for (int ai = 0; ai < 2; ++ai)
#pragma unroll
            for (int m = 0; m < 4; ++m) {
                const int row = row0 + ai * 128 + m * 16;
                float rt[8], sb[8];
#pragma unroll
                for (int n = 0; n < 2; ++n)
#pragma unroll
                    for (int j = 0; j < 4; ++j) {
                        const float a = acc[ai][0][m][n][j] + bv[0][n][j], b = acc[ai][1][m][n][j] + bv[1][n][j];
                        const float ea = __builtin_amdgcn_exp2f(-a * LOG2E), eb = __builtin_amdgcn_exp2f(-b * LOG2E);
                        sb[4 * n + j] = __builtin_amdgcn_rcpf(1.0f + eb);
                        rt[4 * n + j] = (1.0f + eb) * __builtin_amdgcn_rcpf(1.0f + ea);
                    }
                v4u w0, w1;
                w0.x = pk2(rt[0], rt[1]); w0.y = pk2(rt[2], rt[3]); w0.z = pk2(rt[4], rt[5]); w0.w = pk2(rt[6], rt[7]);
                w1.x = pk2(sb[0], sb[1]); w1.y = pk2(sb[2], sb[3]); w1.z = pk2(sb[4], sb[5]); w1.w = pk2(sb[6], sb[7]);
                bf16* p = MG + (size_t)row * 4096 + 128 * t + lc;
                *(v4u*)p = w0; *(v4u*)(p + 2048) = w1;
            }
    }
    __device__ __forceinline__ void operator()(const f32x4 (&acc)[2][2][4][2], const Unit& u, int wr, int wc, int fr, int fq) const {
        const int colt = u.pn * 256;
        const int row0 = u.pm * 256 + wr * 64 + fr, lc = wc * 32 + 8 * fq;
        f32x4 bv[2][2];
        if (colt >= 7168) {
            const int t = (colt - 7168) >> 8;
#pragma unroll
            for (int n = 0; n < 2; ++n) { bv[0][n] = *(const f32x4*)(bias + 7168 + 128 * t + lc + 4 * n); bv[1][n] = *(const f32x4*)(bias + 7168 + D + 128 * t + lc + 4 * n); }
            body_mix(acc, t, row0, lc, bv);
            return;
        }
#pragma unroll
        for (int bj = 0; bj < 2; ++bj)
#pragma unroll
            for (int n = 0; n < 2; ++n) bv[bj][n] = *(const f32x4*)(bias + colt + lc + bj * 128 + 4 * n);
        int mode, ldc, c0; bf16* base;
        if (colt < 2048)      { mode = 0; base = U;  ldc = 2048; c0 = colt; }
        else if (colt < 4096) { mode = 1; base = LG; ldc = 2048; c0 = colt - 2048; }
        else if (colt < 6144) { mode = 0; base = Q;  ldc = 2048; c0 = colt - 4096; }
        else if (colt < 6656) { mode = 0; base = Kb; ldc = 512;  c0 = colt - 6144; }
        else                  { mode = 0; base = Vt; ldc = 512;  c0 = colt - 6656; }
        if (mode == 0) body<0>(acc, base, ldc, c0, row0, lc, bv);
        else body<1>(acc, base, ldc, c0, row0, lc, bv);
    }
};
struct EpiMerge {
    static constexpr bool PERM = true, AFTER_DRAIN = false, DUAL = true;
    const bf16* MG; bf16* OUT;
    __device__ __forceinline__ void mid(f32x4 (&acc)[2][2][4][2], const Unit& u, int wr, int wc, int fr, int fq) const {
        const int row0 = u.pm * 256 + wr * 64 + fr, col0 = u.pn * 256 + wc * 32 + 8 * fq;
#pragma unroll
        for (int ai = 0; ai < 2; ++ai) {
            v4u gg[8];
#pragma unroll
            for (int m = 0; m < 4; ++m)
#pragma unroll
                for (int bj = 0; bj < 2; ++bj) gg[2 * m + bj] = *(const v4u*)(MG + (size_t)(row0 + ai * 128 + m * 16) * 4096 + col0 + bj * 128);
            asm volatile("" : "+v"(gg[0]), "+v"(gg[1]), "+v"(gg[2]), "+v"(gg[3]), "+v"(gg[4]), "+v"(gg[5]), "+v"(gg[6]), "+v"(gg[7]));
#pragma unroll
            for (int m = 0; m < 4; ++m)
#pragma unroll
                for (int bj = 0; bj < 2; ++bj) { const v4u g = gg[2 * m + bj];
                    f32x4 r0, r1;
                    r0[0] = bflo(g.x); r0[1] = bfhi(g.x); r0[2] = bflo(g.y); r0[3] = bfhi(g.y); r1[0] = bflo(g.z); r1[1] = bfhi(g.z); r1[2] = bflo(g.w); r1[3] = bfhi(g.w);
                    acc[ai][bj][m][0] *= r0; acc[ai][bj][m][1] *= r1; }
        }
    }
    __device__ __forceinline__ void operator()(const f32x4 (&acc)[2][2][4][2], const Unit& u, int wr, int wc, int fr, int fq) const {
        const int row0 = u.pm * 256 + wr * 64 + fr, col0 = u.pn * 256 + wc * 32 + 8 * fq;
#pragma unroll
        for (int ai = 0; ai < 2; ++ai) {
            v4u g[4][2];
#pragma unroll
            for (int m = 0; m < 4; ++m)
#pragma unroll
                for (int bj = 0; bj < 2; ++bj) g[m][bj] = *(const v4u*)(MG + (size_t)(row0 + ai * 128 + m * 16) * 4096 + 2048 + col0 + bj * 128);
            asm volatile("" : "+v"(g[0][0]), "+v"(g[0][1]), "+v"(g[1][0]), "+v"(g[1][1]), "+v"(g[2][0]), "+v"(g[2][1]), "+v"(g[3][0]), "+v"(g[3][1]));
#pragma unroll
            for (int m = 0; m < 4; ++m)
#pragma unroll
                for (int bj = 0; bj < 2; ++bj) {
                    const v4u gg = g[m][bj];
                    f32x4 v0 = acc[ai][bj][m][0], v1 = acc[ai][bj][m][1];
                    v0[0] *= bflo(gg.x); v0[1] *= bfhi(gg.x); v0[2] *= bflo(gg.y); v0[3] *= bfhi(gg.y);
                    v1[0] *= bflo(gg.z); v1[1] *= bfhi(gg.z); v1[2] *= bflo(gg.w); v1[3] *= bfhi(gg.w);
                    v4u w; w.x = pk2(v0[0], v0[1]); w.y = pk2(v0[2], v0[3]); w.z = pk2(v1[0], v1[1]); w.w = pk2(v1[2], v1[3]);
                    *(v4u*)(OUT + (size_t)(row0 + ai * 128 + m * 16) * 2048 + col0 + bj * 128) = w;
                }
        }
    }
};
struct EpiRes {
    static constexpr bool PERM = true, AFTER_DRAIN = false, DUAL = false;
    const void* src; bf16* dst; const float* gvec; int src_f32;
    __device__ __forceinline__ void operator()(const f32x4 (&acc)[2][2][4][2], const Unit& u, int wr, int wc, int fr, int fq) const {
        const int row0 = u.pm * 256 + wr * 64 + fr, col0 = u.pn * 256 + wc * 32 + 8 * fq;
        const float* g = gvec + (u.pm >> 4) * (NMOD * D);
        f32x4 gv[2][2];
#pragma unroll
        for (int bj = 0; bj < 2; ++bj)
#pragma unroll
            for (int n = 0; n < 2; ++n) gv[bj][n] = *(const f32x4*)(g + col0 + bj * 128 + 4 * n);
        if (src_f32) {
            const float* s = (const float*)src;
#pragma unroll
            for (int ai = 0; ai < 2; ++ai)
#pragma unroll
                for (int mh = 0; mh < 2; ++mh) {
                    f32x4 xs[2][2][2];
#pragma unroll
                    for (int mm = 0; mm < 2; ++mm)
#pragma unroll
                        for (int bj = 0; bj < 2; ++bj)
#pragma unroll
                            for (int n = 0; n < 2; ++n) xs[mm][bj][n] = *(const f32x4*)(s + (size_t)(row0 + ai * 128 + (2 * mh + mm) * 16) * D + col0 + bj * 128 + 4 * n);
                    asm volatile("" : "+v"(xs[0][0][0]), "+v"(xs[0][0][1]), "+v"(xs[0][1][0]), "+v"(xs[0][1][1]), "+v"(xs[1][0][0]), "+v"(xs[1][0][1]), "+v"(xs[1][1][0]), "+v"(xs[1][1][1]));
#pragma unroll
                    for (int mm = 0; mm < 2; ++mm)
#pragma unroll
                        for (int bj = 0; bj < 2; ++bj) { const int m = 2 * mh + mm;
                            const f32x4 x0 = xs[mm][bj][0] + gv[bj][0] * acc[ai][bj][m][0], x1 = xs[mm][bj][1] + gv[bj][1] * acc[ai][bj][m][1];
                            v4u w; w.x = pk2(x0[0], x0[1]); w.y = pk2(x0[2], x0[3]); w.z = pk2(x1[0], x1[1]); w.w = pk2(x1[2], x1[3]);
                            *(v4u*)(dst + (size_t)(row0 + ai * 128 + m * 16) * D + col0 + bj * 128) = w; }
                }
        } else {
            const bf16* s = (const bf16*)src;
#pragma unroll
            for (int ai = 0; ai < 2; ++ai) {
                v4u xs[4][2];
#pragma unroll
                for (int m = 0; m < 4; ++m)
#pragma unroll
                    for (int bj = 0; bj < 2; ++bj) xs[m][bj] = *(const v4u*)(s + (size_t)(row0 + ai * 128 + m * 16) * D + col0 + bj * 128);
                asm volatile("" : "+v"(xs[0][0]), "+v"(xs[0][1]), "+v"(xs[1][0]), "+v"(xs[1][1]), "+v"(xs[2][0]), "+v"(xs[2][1]), "+v"(xs[3][0]), "+v"(xs[3][1]));
#pragma unroll
                for (int m = 0; m < 4; ++m)
#pragma unroll
                    for (int bj = 0; bj < 2; ++bj) { const v4u t = xs[m][bj];
                        f32x4 x0, x1;
                        x0[0] = bflo(t.x); x0[1] = bfhi(t.x); x0[2] = bflo(t.y); x0[3] = bfhi(t.y); x1[0] = bflo(t.z); x1[1] = bfhi(t.z); x1[2] = bflo(t.w); x1[3] = bfhi(t.w);
                        x0 += gv[bj][0] * acc[ai][bj][m][0]; x1 += gv[bj][1] * acc[ai][bj][m][1];
                        v4u w; w.x = pk2(x0[0], x0[1]); w.y = pk2(x0[2], x0[3]); w.z = pk2(x1[0], x1[1]); w.w = pk2(x1[2], x1[3]);
                        *(v4u*)(dst + (size_t)(row0 + ai * 128 + m * 16) * D + col0 + bj * 128) = w; }
            }
        }
    }
};
struct EpiSwiglu {
    static constexpr bool PERM = true, AFTER_DRAIN = false, DUAL = false;
    bf16* HID;
    __device__ __forceinline__ void operator()(const f32x4 (&acc)[2][2][4][2], const Unit& u, int wr, int wc, int fr, int fq) const {
        const int row0 = u.pm * 256 + wr * 64 + fr, col0 = u.pn * 128 + wc * 32 + 8 * fq;
#pragma unroll
        for (int ai = 0; ai < 2; ++ai)
#pragma unroll
            for (int m = 0; m < 4; ++m) {
                f32x4 o0, o1;
#pragma unroll
                for (int j = 0; j < 4; ++j) { const float g0 = acc[ai][0][m][0][j], g1 = acc[ai][0][m][1][j];
                    o0[j] = g0 * sigmoid_f(g0) * acc[ai][1][m][0][j]; o1[j] = g1 * sigmoid_f(g1) * acc[ai][1][m][1][j]; }
                v4u w; w.x = pk2(o0[0], o0[1]); w.y = pk2(o0[2], o0[3]); w.z = pk2(o1[0], o1[1]); w.w = pk2(o1[2], o1[3]);
                *(v4u*)(HID + (size_t)(row0 + ai * 128 + m * 16) * FFN + col0) = w;
            }
    }
};


__device__ __forceinline__ void transpose_item(const float* W, int K, int N, bf16* WT, int k0, int n0, int drow0, LAS float* scr, int lane) {
#pragma unroll 8
    for (int i = 0; i < 32; ++i) { const int kk = 2 * i + (lane >> 5); scr[kk * 33 + (lane & 31)] = W[(size_t)(k0 + kk) * N + n0 + (lane & 31)]; }
    LDS_WAIT(); asm volatile("" ::: "memory");
    const int c = lane & 7;
#pragma unroll
    for (int j = 0; j < 4; ++j) { const int n = (lane >> 3) + 8 * j; const LAS float* s = scr + (8 * c) * 33 + n;
        v4u o; o.x = pk2(s[0 * 33], s[1 * 33]); o.y = pk2(s[2 * 33], s[3 * 33]); o.z = pk2(s[4 * 33], s[5 * 33]); o.w = pk2(s[6 * 33], s[7 * 33]);
        *(v4u*)(WT + (size_t)(drow0 + n) * K + k0 + 8 * c) = o; }
    LDS_WAIT(); asm volatile("" ::: "memory");
}
__device__ __forceinline__ void transpose_mat(const float* W, int K, int N, bf16* WT, int item, LAS float* scr, int lane, int perm) {
    const int nblk = N / 32, kb = item / nblk, nb = item % nblk, n0 = 32 * nb;
    int drow0 = n0;
    if (perm == 1) { drow0 = (n0 < FFN) ? 256 * (n0 >> 7) + (n0 & 127) : 256 * ((n0 - FFN) >> 7) + 128 + ((n0 - FFN) & 127); }
    if (perm == 2 && n0 >= 7168) { const int c = n0 - 7168;
        drow0 = (c < D) ? 7168 + 256 * (c >> 7) + (c & 127) : 7168 + 256 * ((c - D) >> 7) + 128 + ((c - D) & 127); }
    transpose_item(W, K, N, WT, 64 * kb, n0, drow0, scr, lane);
}

__device__ __forceinline__ void norm_row_bf16(const float* xrow, bf16* orow, const float* g, const float* shift, const float* scale, int lane) {
    const f32x4* xr = (const f32x4*)xrow + lane;
    f32x4 v[8]; float s = 0.f;
#pragma unroll
    for (int j = 0; j < 8; ++j) { v[j] = xr[64 * j]; s += (v[j].x * v[j].x + v[j].y * v[j].y) + (v[j].z * v[j].z + v[j].w * v[j].w); }
    const float inv = 1.0f / sqrtf(wave_sum(s) * (1.f / D) + EPS);
    v2u* o8 = (v2u*)orow + lane;
#pragma unroll
    for (int j = 0; j < 8; ++j) {
        const f32x4 gg = ((const f32x4*)g)[lane + 64 * j], sh = ((const f32x4*)shift)[lane + 64 * j], sc = ((const f32x4*)scale)[lane + 64 * j];
        const f32x4 hh = (v[j] * inv) * gg * (sc + 1.0f) + sh;
        v2u w; w.x = pk2(hh.x, hh.y); w.y = pk2(hh.z, hh.w); o8[64 * j] = w;
    }
}
__device__ __forceinline__ void norm_row_bf16in(const bf16* xrow, bf16* orow, const float* g, const float* shift, const float* scale, int lane) {
    const v4u* xr = (const v4u*)xrow + lane;
    float v[4][8]; float s = 0.f;
#pragma unroll
    for (int j = 0; j < 4; ++j) { const v4u t = xr[64 * j];
        v[j][0] = bflo(t.x); v[j][1] = bfhi(t.x); v[j][2] = bflo(t.y); v[j][3] = bfhi(t.y); v[j][4] = bflo(t.z); v[j][5] = bfhi(t.z); v[j][6] = bflo(t.w); v[j][7] = bfhi(t.w);
#pragma unroll
        for (int e = 0; e < 8; ++e) s += v[j][e] * v[j][e]; }
    const float inv = 1.0f / sqrtf(wave_sum(s) * (1.f / D) + EPS);
    v4u* o16 = (v4u*)orow + lane;
#pragma unroll
    for (int j = 0; j < 4; ++j) {
        float hh[8];
#pragma unroll
        for (int q = 0; q < 2; ++q) {
            const f32x4 gg = ((const f32x4*)g)[2 * lane + 128 * j + q], sh = ((const f32x4*)shift)[2 * lane + 128 * j + q], sc = ((const f32x4*)scale)[2 * lane + 128 * j + q];
#pragma unroll
            for (int e = 0; e < 4; ++e) hh[4 * q + e] = (v[j][4 * q + e] * inv) * gg[e] * (sc[e] + 1.0f) + sh[e];
        }
        v4u w; w.x = pk2(hh[0], hh[1]); w.y = pk2(hh[2], hh[3]); w.z = pk2(hh[4], hh[5]); w.w = pk2(hh[6], hh[7]); o16[64 * j] = w;
    }
}
__device__ __forceinline__ void final_norm_row(const bf16* xrow, float* orow, const float* g, int lane) {
    const v4u* xr = (const v4u*)xrow + lane;
    float v[4][8]; float s = 0.f;
#pragma unroll
    for (int j = 0; j < 4; ++j) { const v4u t = xr[64 * j];
        v[j][0] = bflo(t.x); v[j][1] = bfhi(t.x); v[j][2] = bflo(t.y); v[j][3] = bfhi(t.y); v[j][4] = bflo(t.z); v[j][5] = bfhi(t.z); v[j][6] = bflo(t.w); v[j][7] = bfhi(t.w);
#pragma unroll
        for (int e = 0; e < 8; ++e) s += v[j][e] * v[j][e]; }
    const float inv = 1.0f / sqrtf(wave_sum(s) * (1.f / D) + EPS);
#pragma unroll
    for (int j = 0; j < 4; ++j)
#pragma unroll
        for (int q = 0; q < 2; ++q) { const f32x4 gg = ((const f32x4*)g)[2 * lane + 128 * j + q]; f32x4 o;
#pragma unroll
            for (int e = 0; e < 4; ++e) o[e] = (v[j][4 * q + e] * inv) * gg[e];
            ((f32x4*)orow)[2 * lane + 128 * j + q] = o; }
}

#define MFMA32(a, b, c) __builtin_amdgcn_mfma_f32_32x32x16_bf16((a), (b), (c), 0, 0, 0)
__device__ __forceinline__ int crow(int reg, int h) { return (reg & 3) + 8 * (reg >> 2) + 4 * h; }
#define FENCE8(a) asm volatile("" : "+v"((a)[0]), "+v"((a)[1]), "+v"((a)[2]), "+v"((a)[3]), "+v"((a)[4]), "+v"((a)[5]), "+v"((a)[6]), "+v"((a)[7]))
__device__ __forceinline__ void attn_subblock(const LAS unsigned char* Ks, const LAS unsigned char* Vs, const bf16x8 (&bq)[8], bf16x8 (&bqn)[8], const bf16* qn, bool PREFETCH, bf16* orow, int t0, int n, float sink2, int r, int h) {
    constexpr int KRS = 272, VRS = 320;
    const int kt0 = t0 >> 5;
        f32x16 X[5];
        bf16x8 kf[2][8];
        {   const LAS unsigned char* kp = Ks + (32 * kt0 + r) * KRS + 16 * h;
#pragma unroll
            for (int ks = 0; ks < 8; ++ks) kf[0][ks] = *(const LAS bf16x8*)(kp + 32 * ks); }
#pragma unroll
        for (int kk = 0; kk < 5; ++kk) {
            if (kk < 4) { const LAS unsigned char* kp = Ks + (32 * (kt0 + kk + 1) + r) * KRS + 16 * h;
#pragma unroll
                for (int ks = 0; ks < 8; ++ks) kf[(kk + 1) & 1][ks] = *(const LAS bf16x8*)(kp + 32 * ks); }
            FENCE8(kf[kk & 1]);
#pragma unroll
            for (int i = 0; i < 16; ++i) X[kk][i] = 0.f;
#pragma unroll
            for (int ks = 0; ks < 8; ++ks) X[kk] = MFMA32(kf[kk & 1][ks], bq[ks], X[kk]);
        }
        if (PREFETCH) {
#pragma unroll
            for (int ks = 0; ks < 8; ++ks) bqn[ks] = *(const bf16x8*)(qn + 16 * ks); }
        const int qi = t0 + r; float mraw = -__builtin_inff();
#pragma unroll
        for (int kk = 0; kk < 5; ++kk) {
            const bool tile_ok = (n > 0) || (kt0 + kk >= 4);
#pragma unroll
            for (int i = 0; i < 16; ++i) { const int kw = 32 * (kt0 + kk) + crow(i, h);
                bool valid = tile_ok;
                if (kk == 0) valid = valid && (kw > qi);
                if (kk == 4) valid = valid && (kw <= qi + 128);
                const float s = valid ? X[kk][i] : -__builtin_inff(); X[kk][i] = s; mraw = fmaxf(mraw, s); }
        }
        mraw = fmaxf(mraw, __shfl_xor(mraw, 32));
        const float mx = fmaxf(sink2, mraw * SC2);
        float sum = 0.f;
        f32x16 O[4];
#pragma unroll
        for (int dt = 0; dt < 4; ++dt)
#pragma unroll
            for (int i = 0; i < 16; ++i) O[dt][i] = 0.f;
#pragma unroll
        for (int kk = 0; kk < 5; ++kk) {
            v4u av[8];
            const LAS unsigned char* vp = Vs + (32 * (kt0 + kk) + 4 * h + ((r >> 2) & 3)) * VRS + (16 * ((r >> 4) & 1) + 4 * (r & 3)) * 2;
#pragma unroll
            for (int s2 = 0; s2 < 2; ++s2)
#pragma unroll
                for (int dt = 0; dt < 4; ++dt) {
                    const v2u lo = __builtin_bit_cast(v2u, __builtin_amdgcn_ds_read_tr16_b64_v4i16((LAS v4i16_t*)(vp + 16 * s2 * VRS + 64 * dt)));
                    const v2u hi = __builtin_bit_cast(v2u, __builtin_amdgcn_ds_read_tr16_b64_v4i16((LAS v4i16_t*)(vp + 16 * s2 * VRS + 64 * dt + 8 * VRS)));
                    v4u a; a.x = lo.x; a.y = lo.y; a.z = hi.x; a.w = hi.y; av[4 * s2 + dt] = a; }
#pragma unroll
            for (int i = 0; i < 16; ++i) { const float p = __builtin_amdgcn_exp2f(__builtin_fmaf(X[kk][i], SC2, -mx)); X[kk][i] = p; sum += p; }
            FENCE8(av);
#pragma unroll
            for (int s2 = 0; s2 < 2; ++s2) {
                v4u pw; pw.x = pk2(X[kk][8 * s2 + 0], X[kk][8 * s2 + 1]); pw.y = pk2(X[kk][8 * s2 + 2], X[kk][8 * s2 + 3]);
                pw.z = pk2(X[kk][8 * s2 + 4], X[kk][8 * s2 + 5]); pw.w = pk2(X[kk][8 * s2 + 6], X[kk][8 * s2 + 7]);
                const bf16x8 pb = __builtin_bit_cast(bf16x8, pw);
#pragma unroll
                for (int dt = 0; dt < 4; ++dt) O[dt] = MFMA32(__builtin_bit_cast(bf16x8, av[4 * s2 + dt]), pb, O[dt]);
            }
        }
        sum += __shfl_xor(sum, 32);
        const float inv = 1.0f / (sum + __builtin_amdgcn_exp2f(sink2 - mx));
#pragma unroll
        for (int dt = 0; dt < 4; ++dt)
#pragma unroll
            for (int g4 = 0; g4 < 4; ++g4) { v2u w; w.x = pk2(O[dt][4 * g4] * inv, O[dt][4 * g4 + 1] * inv); w.y = pk2(O[dt][4 * g4 + 2] * inv, O[dt][4 * g4 + 3] * inv);
                *(v2u*)(orow + 32 * dt + 8 * g4 + 4 * h) = w; }
}
__device__ __forceinline__ void attn_unit(LAS unsigned char* lds, int b, int n, int hkv, const bf16* QA, bf16* OA, const bf16* Kb, const bf16* Vt, const float* sinks_l, int tid, int wave, int lane) {
    constexpr int KRS = 272, VRS = 320;
    LAS unsigned char* Ks = lds; LAS unsigned char* Vs = lds + 256 * KRS;
    const int blk0 = b * SEQ + n * 128, prev0 = n > 0 ? blk0 - 128 : blk0;
    const int g = wave >> 1, rh = wave & 1, head = hkv * 4 + g, r = lane & 31, h = lane >> 5;
    bf16x8 bqA[8], bqB[8];
    {   const bf16* q0 = QA + (size_t)(blk0 + 64 * rh + r) * D + head * 128 + 8 * h;
#pragma unroll
        for (int ks = 0; ks < 8; ++ks) bqA[ks] = *(const bf16x8*)(q0 + 16 * ks); }
    {
        v4u kv[8], vv[8];
#pragma unroll
        for (int i = 0; i < 8; ++i) { const int row = (tid >> 4) + 32 * i, ch = tid & 15; const int tok = row < 128 ? prev0 + row : blk0 + row - 128;
            kv[i] = *(const v4u*)(Kb + (size_t)tok * 512 + hkv * 128 + ch * 8); }
#pragma unroll
        for (int i = 0; i < 8; ++i) { const int row = (tid >> 4) + 32 * i, ch = tid & 15; const int tok = row < 128 ? prev0 + row : blk0 + row - 128;
            vv[i] = *(const v4u*)(Vt + (size_t)tok * 512 + hkv * 128 + ch * 8); }
        FENCE8(kv);
#pragma unroll
        for (int i = 0; i < 8; ++i) { const int row = (tid >> 4) + 32 * i, ch = tid & 15; *(LAS v4u*)(Ks + row * KRS + ch * 16) = kv[i]; }
        FENCE8(vv);
#pragma unroll
        for (int i = 0; i < 8; ++i) { const int row = (tid >> 4) + 32 * i, ch = tid & 15; *(LAS v4u*)(Vs + row * VRS + ch * 16) = vv[i]; }
    }
    const float sink2 = sinks_l[head] * LOG2E;
    FENCE8(bqA);
    __syncthreads();
#pragma unroll 1
    for (int sb = 0; sb < 2; ++sb) {
        const size_t rowoff = (size_t)(blk0 + 64 * rh + 32 * sb + r) * D + head * 128;
        attn_subblock(Ks, Vs, bqA, bqB, QA + rowoff + (size_t)32 * D + 8 * h, sb == 0, OA + rowoff, 64 * rh + 32 * sb, n, sink2, r, h);
        if (sb == 0) {
#pragma unroll
            for (int ks = 0; ks < 8; ++ks) bqA[ks] = bqB[ks]; }
    }
    __syncthreads();
}

__device__ __forceinline__ void lru_load_rows(v4u (&dst)[11], const bf16* U, int b, int s, int tq, int chan0) {
#pragma unroll
    for (int i = 0; i < 11; ++i) { const int pos = 256 * s + 8 * tq - 3 + i; v4u v; v.x = 0u; v.y = 0u; v.z = 0u; v.w = 0u;
        if (pos >= 0 && pos < SEQ) v = *(const v4u*)(U + (size_t)(b * SEQ + pos) * D + chan0);
        dst[i] = v; }
}
__device__ __forceinline__ void lru_seq(LAS unsigned char* lds, int b, int hd, int ct, const bf16* U, const bf16* LG, bf16* YL,
                                        const float* conv_w, const float* conv_b, const float* ba, const float* bx, const float* lam, const bf16* WAt, const bf16* WXt,
                                        int tid, int wave, int lane) {
    constexpr int RS = 272, TS = 80;
    LAS unsigned char* UCs = lds; LAS unsigned char* WAs = lds + 256 * RS; LAS unsigned char* WXs = WAs + 32 * RS;
    LAS float* EX = (LAS float*)(WXs + 32 * RS);
    LAS float* CW = EX + 512;
    LAS unsigned char* GL0 = (LAS unsigned char*)(CW + 640);
    LAS unsigned char* YTs = GL0 + 2 * 256 * TS;
    { const int row = tid >> 4, chk = tid & 15;
        *(LAS v4u*)(WAs + row * RS + chk * 16) = *(const v4u*)(WAt + (size_t)(hd * 128 + 32 * ct + row) * 128 + chk * 8);
        *(LAS v4u*)(WXs + row * RS + chk * 16) = *(const v4u*)(WXt + (size_t)(hd * 128 + 32 * ct + row) * 128 + chk * 8); }
    for (int i = tid; i < 640; i += NWAVES * 64) { const int k = i >> 7, c = i & 127; CW[i] = (k < 4) ? conv_w[k * D + hd * 128 + c] : conv_b[hd * 128 + c]; }
    const int c8 = tid & 15, tq = tid >> 4, chan0 = hd * 128 + c8 * 8;
    const int r = lane & 31, h = lane >> 5, ch = hd * 128 + 32 * ct + r;
    const float bav = ba[ch], bxv = bx[ch];
    const float sp8 = 8.0f * LOG2E * log1pf(expf(-lam[ch]));
    const int grow = tid >> 2, gq = tid & 3;
    float carry = 0.f;
    v4u raw[11], glr[2];
    lru_load_rows(raw, U, b, 0, tq, chan0);
#pragma unroll
    for (int q = 0; q < 2; ++q) glr[q] = *(const v4u*)(LG + (size_t)(b * SEQ + grow + 128 * q) * D + hd * 128 + 32 * ct + gq * 8);
    __syncthreads();
#pragma unroll 1
    for (int s = 0; s < 16; ++s) {
        {
            f32x4 cwv[5][2];
#pragma unroll
            for (int k = 0; k < 5; ++k) { cwv[k][0] = *(const LAS f32x4*)(CW + k * 128 + c8 * 8); cwv[k][1] = *(const LAS f32x4*)(CW + k * 128 + c8 * 8 + 4); }
#pragma unroll
            for (int j = 0; j < 8; ++j) {
                f32x4 o0 = cwv[4][0], o1 = cwv[4][1];
#pragma unroll
                for (int k = 0; k < 4; ++k) { const v4u v = raw[j + k];
                    o0[0] += cwv[k][0][0] * bflo(v.x); o0[1] += cwv[k][0][1] * bfhi(v.x); o0[2] += cwv[k][0][2] * bflo(v.y); o0[3] += cwv[k][0][3] * bfhi(v.y);
                    o1[0] += cwv[k][1][0] * bflo(v.z); o1[1] += cwv[k][1][1] * bfhi(v.z); o1[2] += cwv[k][1][2] * bflo(v.w); o1[3] += cwv[k][1][3] * bfhi(v.w); }
                v4u w; w.x = pk2(o0[0], o0[1]); w.y = pk2(o0[2], o0[3]); w.z = pk2(o1[0], o1[1]); w.w = pk2(o1[2], o1[3]);
                *(LAS v4u*)(UCs + (8 * tq + j) * RS + c8 * 16) = w;
            }
#pragma unroll
            for (int q = 0; q < 2; ++q) *(LAS v4u*)(GL0 + (s & 1) * 256 * TS + (grow + 128 * q) * TS + gq * 16) = glr[q];
        }
        if (s < 15) {
            const bf16* nb = U + (size_t)(b * SEQ + 256 * (s + 1) + 8 * tq - 3) * D + chan0;
#pragma unroll
            for (int i = 0; i < 11; ++i) raw[i] = *(const v4u*)(nb + (size_t)i * D);
#pragma unroll
            for (int q = 0; q < 2; ++q) glr[q] = *(const v4u*)(LG + (size_t)(b * SEQ + 256 * (s + 1) + grow + 128 * q) * D + hd * 128 + 32 * ct + gq * 8);
        }
        __syncthreads();
        if (s > 0) {
#pragma unroll
            for (int q = 0; q < 2; ++q) *(v4u*)(YL + (size_t)(b * SEQ + 256 * (s - 1) + grow + 128 * q) * D + hd * 128 + 32 * ct + gq * 8) = *(const LAS v4u*)(YTs + (grow + 128 * q) * TS + gq * 16);
        }
        f32x16 ga, gx;
#pragma unroll
        for (int i = 0; i < 16; ++i) { ga[i] = 0.f; gx[i] = 0.f; }
        {   const LAS unsigned char* ap = UCs + (32 * wave + r) * RS + 16 * h;
            const LAS unsigned char* wap = WAs + r * RS + 16 * h;
            const LAS unsigned char* wxp = WXs + r * RS + 16 * h;
#pragma unroll
            for (int ks = 0; ks < 8; ++ks) { const bf16x8 a = *(const LAS bf16x8*)(ap + 32 * ks);
                ga = MFMA32(a, *(const LAS bf16x8*)(wap + 32 * ks), ga); gx = MFMA32(a, *(const LAS bf16x8*)(wxp + 32 * ks), gx); } }
        float P[16], Hl[16];
#pragma unroll
        for (int i = 0; i < 16; i += 2) {
            typedef float f2 __attribute__((ext_vector_type(2)));
            f2 ucv; ucv.x = bf2f(*(const LAS bf16*)(UCs + (32 * wave + crow(i, h)) * RS + (32 * ct + r) * 2)); ucv.y = bf2f(*(const LAS bf16*)(UCs + (32 * wave + crow(i + 1, h)) * RS + (32 * ct + r) * 2));
            f2 za; za.x = ga[i]; za.y = ga[i + 1]; f2 zx; zx.x = gx[i]; zx.y = gx[i + 1];
            za = (za + bav) * (-LOG2E); zx = (zx + bxv) * (-LOG2E);
            f2 ea; ea.x = __builtin_amdgcn_exp2f(za.x); ea.y = __builtin_amdgcn_exp2f(za.y);
            f2 ex; ex.x = __builtin_amdgcn_exp2f(zx.x); ex.y = __builtin_amdgcn_exp2f(zx.y);
            ea = ea + 1.0f; ex = ex + 1.0f;
            f2 rg; rg.x = __builtin_amdgcn_rcpf(ea.x); rg.y = __builtin_amdgcn_rcpf(ea.y);
            f2 ig; ig.x = __builtin_amdgcn_rcpf(ex.x); ig.y = __builtin_amdgcn_rcpf(ex.y);
            const f2 la = rg * (-sp8);
            f2 a; a.x = __builtin_amdgcn_exp2f(la.x); a.y = __builtin_amdgcn_exp2f(la.y);
            const f2 om = 1.0f - a * a;
            f2 beta; beta.x = __builtin_amdgcn_sqrtf(om.x); beta.y = __builtin_amdgcn_sqrtf(om.y);
            const f2 inp = beta * ig * ucv;
            P[i] = a.x; P[i + 1] = a.y; Hl[i] = inp.x; Hl[i + 1] = inp.y;
        }
        float Ar[4], Hr[4], ArP[4], HrP[4], cin0[4], apre[4];
#pragma unroll
        for (int g = 0; g < 4; ++g) {
#pragma unroll
            for (int e = 1; e < 4; ++e) { Hl[4 * g + e] = P[4 * g + e] * Hl[4 * g + e - 1] + Hl[4 * g + e]; P[4 * g + e] = P[4 * g + e] * P[4 * g + e - 1]; }
            Ar[g] = P[4 * g + 3]; Hr[g] = Hl[4 * g + 3];
            ArP[g] = __shfl_xor(Ar[g], 32); HrP[g] = __shfl_xor(Hr[g], 32);
        }
        float cur = 0.f, curA = 1.f;
#pragma unroll
        for (int g = 0; g < 4; ++g) {
            const float A0 = h ? ArP[g] : Ar[g], H0 = h ? HrP[g] : Hr[g], A1 = h ? Ar[g] : ArP[g], H1 = h ? Hr[g] : HrP[g];
            const float c0 = cur, p0 = curA; cur = A0 * cur + H0; curA *= A0;
            const float c1 = cur, p1 = curA; cur = A1 * cur + H1; curA *= A1;
            cin0[g] = h ? c1 : c0; apre[g] = h ? p1 : p0;
        }
        if (h == 0) { EX[wave * 64 + r] = curA; EX[wave * 64 + 32 + r] = cur; }
        __syncthreads();
        float cin = carry, mycin = 0.f;
#pragma unroll
        for (int w = 0; w < 8; ++w) { const float a = EX[w * 64 + r], hh = EX[w * 64 + 32 + r]; if (w == wave) mycin = cin; cin = a * cin + hh; }
        carry = cin;
#pragma unroll
        for (int g = 0; g < 4; ++g) {
            const float cg_ = cin0[g] + apre[g] * mycin;
#pragma unroll
            for (int e = 0; e < 4; ++e) {
                const int trow = 32 * wave + 8 * g + 4 * h + e;
                const float hv = Hl[4 * g + e] + P[4 * g + e] * cg_;
                const float gate = bf2f(*(const LAS bf16*)(GL0 + (s & 1) * 256 * TS + trow * TS + r * 2));
                *(LAS bf16*)(YTs + trow * TS + r * 2) = (bf16)(pk2(hv * gate, 0.f) & 0xffffu);
            }
        }
    }
    __syncthreads();
#pragma unroll
    for (int q = 0; q < 2; ++q) *(v4u*)(YL + (size_t)(b * SEQ + 256 * 15 + grow + 128 * q) * D + hd * 128 + 32 * ct + gq * 8) = *(const LAS v4u*)(YTs + (grow + 128 * q) * TS + gq * 16);
    __syncthreads();
}

#define XB_TMO      128
#define XB_XCNT(j)  (256  + 64 * (j))
#define XB_XSUB(j)  (1280 + 64 * (j))
#define XB_XGEN(j)  (2304 + 64 * (j))
#define XB_TOP      3328
#define XB_TOPGEN   3392
#define XCD_BAR_WORDS 3456
#define XB_SPIN_CAP (1u << 21)
__device__ __forceinline__ unsigned xb_ld(unsigned* p)              { return __hip_atomic_load(p, __ATOMIC_RELAXED, __HIP_MEMORY_SCOPE_AGENT); }
__device__ __forceinline__ unsigned xb_add(unsigned* p, unsigned v) { return __hip_atomic_fetch_add(p, v, __ATOMIC_RELAXED, __HIP_MEMORY_SCOPE_AGENT); }
__device__ __forceinline__ unsigned xb_xcc_id() { return (unsigned)__builtin_amdgcn_s_getreg((3 << 11) | 20) & 0xFu; }
#define XB_SPIN(cond, bar) do { unsigned _sp = 0; while (cond) { __builtin_amdgcn_s_sleep(1); \
    if ((++_sp & 255u) == 0u) { if (xb_ld(&(bar)[XB_TMO])) break; if (_sp > XB_SPIN_CAP) { atomicAdd(&(bar)[XB_TMO], 1u); break; } } } } while (0)
struct XcdBarrier { unsigned* bar; unsigned x; volatile LAS unsigned* st; };
__device__ __forceinline__ XcdBarrier xcd_barrier_post(unsigned* bar, volatile LAS unsigned* st) {
    XcdBarrier b; b.bar = bar; b.x = xb_xcc_id(); b.st = st;
    if (threadIdx.x == 0) st[2] = xb_add(&bar[XB_XCNT(b.x)], 1u);
    return b;
}
__device__ __forceinline__ void xcd_barrier_complete(unsigned* bar, unsigned x, unsigned& nloc, unsigned& nx) {
    const unsigned G = gridDim.x * gridDim.y * gridDim.z;
    unsigned sum, cnt, mine, sp = 0u;
    for (;;) {
        sum = 0u; cnt = 0u; mine = 0u;
#pragma unroll
        for (unsigned j = 0; j < 16; ++j) { const unsigned c = xb_ld(&bar[XB_XCNT(j)]); sum += c; cnt += (c > 0u) ? 1u : 0u; mine = (j == x) ? c : mine; }
        if (sum == G) break;
        __builtin_amdgcn_s_sleep(1);
        if ((++sp & 255u) == 0u) { if (xb_ld(&bar[XB_TMO])) break; if (sp > XB_SPIN_CAP) { atomicAdd(&bar[XB_TMO], 1u); break; } }
    }
    nloc = mine > 0u ? mine : 1u; nx = cnt > 0u ? cnt : 1u;
}
__device__ __forceinline__ void xcd_barrier(const XcdBarrier& b) {
    asm volatile("s_waitcnt vmcnt(0)" ::: "memory");
    __syncthreads();
    if (threadIdx.x == 0) {
        unsigned* bar = b.bar;
        __builtin_amdgcn_s_waitcnt(0);
        unsigned nloc = b.st[0], nx = b.st[1];
        if (nloc == 0u) { xcd_barrier_complete(bar, b.x, nloc, nx); b.st[0] = nloc; b.st[1] = nx; }
        const unsigned old = xb_add(&bar[XB_XSUB(b.x)], 1u);
        const unsigned gen = old / nloc;
        if (old + 1u == (gen + 1u) * nloc) {
            __builtin_amdgcn_fence(__ATOMIC_RELEASE, "agent");
            asm volatile("s_waitcnt vmcnt(0)" ::: "memory");
            const unsigned og = xb_add(&bar[XB_TOP], 1u);
            const unsigned tg = og / nx;
            if (og + 1u == (tg + 1u) * nx) xb_add(&bar[XB_TOPGEN], 1u);
            else XB_SPIN(xb_ld(&bar[XB_TOPGEN]) == tg, bar);
            __builtin_amdgcn_fence(__ATOMIC_ACQUIRE, "agent");
            xb_add(&bar[XB_XGEN(b.x)], 1u);
            asm volatile("s_waitcnt vmcnt(0)" ::: "memory");
        } else {
            XB_SPIN(xb_ld(&bar[XB_XGEN(b.x)]) == gen, bar);
            __builtin_amdgcn_fence(__ATOMIC_ACQUIRE, "agent");
            asm volatile("s_waitcnt vmcnt(0)" ::: "memory");
        }
    }
    __syncthreads();
}

struct Args { const float* in[22]; float* out; unsigned char* ws; };
enum { I_X = 0, I_C, I_ADAW, I_ADAB, I_N1G, I_WIN, I_BIN, I_CONVW, I_CONVB, I_WA, I_BA, I_WX, I_BX, I_LAM, I_SINKS, I_WLO, I_WAO, I_WO, I_N2G, I_WFI, I_WFO, I_FG };

__global__ void __launch_bounds__(NWAVES * 64, 2) mk_fwd(Args args) {
    extern __shared__ __attribute__((aligned(16))) unsigned char lds_raw[];
    cg::grid_group grid = cg::this_grid();
    LAS unsigned char* lds = (LAS unsigned char*)lds_raw;
#define GSYNC() xcd_barrier(xbar)
#define FRESH_TID() int tid_f = threadIdx.x; asm volatile("" : "+v"(tid_f)); const int tid = tid_f, lane = tid_f & 63; (void)tid; (void)lane
    const int wave = __builtin_amdgcn_readfirstlane((int)threadIdx.x >> 6);
    const int G = gridDim.x, bx = blockIdx.x;
    const int vcu = (G % 8 == 0) ? (bx % 8) * (G / 8) + bx / 8 : bx;
    const int gw = vcu * NWAVES + wave, NGW = G * NWAVES;
    unsigned char* ws = args.ws;
    volatile LAS unsigned* xst = (volatile LAS unsigned*)(lds + LDS_BYTES - 64);
    if (threadIdx.x == 0) { xst[0] = 0u; xst[1] = 0u; xst[2] = 0u; xst[3] = 0u; }
    __syncthreads();
    const XcdBarrier xbar = xcd_barrier_post((unsigned*)(ws + WS_BAR), xst);
    float* MODP = (float*)(ws + WS_MODP); float* MOD = (float*)(ws + WS_MOD);
    bf16* Hb = (bf16*)(ws + WS_H); bf16* Ub = (bf16*)(ws + WS_U); bf16* LGb = (bf16*)(ws + WS_LG); bf16* Qb = (bf16*)(ws + WS_Q);
    bf16* Kbuf = (bf16*)(ws + WS_K); bf16* Vtb = (bf16*)(ws + WS_VT); bf16* MGb = (bf16*)(ws + WS_MG); bf16* HIDb = (bf16*)(ws + WS_HID);
    float* xout = args.out; bf16* XB = (bf16*)(ws + WS_XB);

    {
        FRESH_TID();
        LAS float* scr = (LAS float*)(lds + wave * 16384);
        for (int it = gw; it < 2 * 48 * 16; it += NGW) {
            const int ks = it & 15, nb = (it >> 4) % 48, l = it / (16 * 48);
            const float* cp = args.in[I_C];
            float sv[4][2];
#pragma unroll
            for (int b = 0; b < 4; ++b)
#pragma unroll
                for (int q = 0; q < 2; ++q) { const float c = cp[b * D + ks * 128 + q * 64 + lane]; sv[b][q] = c * sigmoid_f(c); }
            const float* wp = args.in[I_ADAW] + ((size_t)l * D + ks * 128) * (NMOD * D) + nb * 256 + lane * 4;
            f32x4 acc[4];
#pragma unroll
            for (int b = 0; b < 4; ++b) acc[b] = (f32x4){0.f, 0.f, 0.f, 0.f};
#pragma unroll
            for (int q = 0; q < 2; ++q)
#pragma unroll 8
                for (int kk = 0; kk < 64; ++kk) {
                    const f32x4 w = *(const f32x4*)(wp + (size_t)(q * 64 + kk) * (NMOD * D));
#pragma unroll
                    for (int b = 0; b < 4; ++b) acc[b] += w * __shfl(sv[b][q], kk);
                }
#pragma unroll
            for (int b = 0; b < 4; ++b) *(f32x4*)(MODP + ((size_t)((l * 16 + ks) * 4 + b)) * (NMOD * D) + nb * 256 + lane * 4) = acc[b];
        }
        constexpr int I_IN = 32 * (CIN / 32), I_SQ = 32 * (D / 32), I_FO = (FFN / 64) * (D / 32), I_LR = 16 * 2 * 4;
        constexpr int PER_L = 2 * I_IN + 3 * I_SQ + I_FO + 2 * I_LR;
        for (int it = gw; it < 2 * PER_L; it += NGW) {
            const int l = it / PER_L; int rr = it % PER_L;
            unsigned char* wl = ws + WS_W + (size_t)l * W_LAYER;
            if (rr < I_IN) { transpose_mat(args.in[I_WIN] + (size_t)l * D * CIN, D, CIN, (bf16*)(wl + WO_IN), rr, scr, lane, 2); continue; } rr -= I_IN;
            if (rr < I_IN) { transpose_mat(args.in[I_WFI] + (size_t)l * D * CIN, D, CIN, (bf16*)(wl + WO_FI), rr, scr, lane, 1); continue; } rr -= I_IN;
            if (rr < I_SQ) { transpose_mat(args.in[I_WLO] + (size_t)l * D * D, D, D, (bf16*)(wl + WO_LO), rr, scr, lane, 0); continue; } rr -= I_SQ;
            if (rr < I_SQ) { transpose_mat(args.in[I_WAO] + (size_t)l * D * D, D, D, (bf16*)(wl + WO_AO), rr, scr, lane, 0); continue; } rr -= I_SQ;
            if (rr < I_SQ) { transpose_mat(args.in[I_WO] + (size_t)l * D * D, D, D, (bf16*)(wl + WO_O), rr, scr, lane, 0); continue; } rr -= I_SQ;
            if (rr < I_FO) { transpose_mat(args.in[I_WFO] + (size_t)l * FFN * D, FFN, D, (bf16*)(wl + WO_FO), rr, scr, lane, 0); continue; } rr -= I_FO;
            {
                const bool second = rr >= I_LR; if (second) rr -= I_LR;
                const int hd = rr >> 3, sub = rr & 7;
                const float* src = args.in[second ? I_WX : I_WA] + ((size_t)l * 16 + hd) * 128 * 128;
                bf16* dst = (bf16*)(wl + (second ? WO_WX : WO_WA)) + (size_t)hd * 128 * 128;
                transpose_mat(src, 128, 128, dst, sub, scr, lane, 0);
            }
        }
    }
    GSYNC();
    if (args.ws == nullptr) grid.sync();
    int vb = bx;
    {   if (threadIdx.x == 0) { unsigned* bar = (unsigned*)(ws + WS_BAR); bool ok = (G % 8 == 0);
            for (unsigned j = 0; j < 16; ++j) { const unsigned c = xb_ld(&bar[XB_XCNT(j)]); ok = ok && (c == (j < 8 ? (unsigned)(G / 8) : 0u)); }
            xst[3] = ok ? (xbar.x + 8u * xst[2]) : (unsigned)bx; }
        __syncthreads();
        vb = __builtin_amdgcn_readfirstlane((int)xst[3]); }
    const int vgw = ((G % 8 == 0) ? (vb % 8) * (G / 8) + vb / 8 : vb) * NWAVES + wave;
    { FRESH_TID();
    for (int i = bx * (NWAVES * 64) + tid; i < 2 * 4 * NMOD * D; i += G * NWAVES * 64) {
        const int n = i % (NMOD * D), lb = i / (NMOD * D), l = lb >> 2, b = lb & 3;
        float s = args.in[I_ADAB][l * NMOD * D + n];
#pragma unroll
        for (int ks = 0; ks < 16; ++ks) s += MODP[((size_t)((l * 16 + ks) * 4 + b)) * (NMOD * D) + n];
        MOD[i] = s;
    } }
    GSYNC();

#pragma unroll 1
    for (int l = 0; l < DEPTH; ++l) {
        const float* modl = MOD + (size_t)l * 4 * NMOD * D;
        unsigned char* wl = ws + WS_W + (size_t)l * W_LAYER;
        { FRESH_TID();
        for (int m = vgw; m < M; m += NGW) { const float* mb = modl + (m >> 12) * (NMOD * D);
            if (l == 0) norm_row_bf16(args.in[I_X] + (size_t)m * D, Hb + (size_t)m * D, args.in[I_N1G] + l * D, mb, mb + D, lane);
            else norm_row_bf16in(XB + (size_t)m * D, Hb + (size_t)m * D, args.in[I_N1G] + l * D, mb, mb + D, lane); } }
        GSYNC();
        {   pg8::Gemm g{Hb, (const bf16*)(wl + WO_IN), M, CIN, D}; pg8::StaticOrder S; S.init(M, CIN, G, vb);
            EpiIn E{args.in[I_BIN] + (size_t)l * CIN, Ub, LGb, Qb, Kbuf, Vtb, MGb};
            pg8::gemm_phase<EpiIn, pg8::StaticOrder, true, true>(lds, g, S, E); }
        GSYNC();
        {
            FRESH_TID();
            for (int u = vb; u < 4 * 16 * 4; u += G) {
                const int xc = u & 7, rk = u >> 3, ct = rk & 3, bh = xc + 8 * (rk >> 2), hd = bh & 15, b = bh >> 4;
                lru_seq(lds, b, hd, ct, Ub, LGb, Hb, args.in[I_CONVW] + (size_t)l * 4 * D, args.in[I_CONVB] + l * D, args.in[I_BA] + l * D, args.in[I_BX] + l * D,
                        args.in[I_LAM] + l * D, (const bf16*)(wl + WO_WA), (const bf16*)(wl + WO_WX), tid, wave, lane); }
            for (int u = vb; u < 4 * 32 * 4; u += G) { const int hkv = u & 3, n = (u >> 2) & 31, b = u >> 7;
                attn_unit(lds, b, n, hkv, Qb, Qb, Kbuf, Vtb, args.in[I_SINKS] + l * 16, tid, wave, lane); }
        }
        GSYNC();
        {   pg8::Gemm g{Hb, (const bf16*)(wl + WO_LO), M, D, D, Qb, (const bf16*)(wl + WO_AO)}; pg8::StaticOrder S; S.init(M, D, G, vb);
            EpiMerge E{MGb, Ub};
            pg8::gemm_phase<EpiMerge, pg8::StaticOrder, true, true>(lds, g, S, E); }
        GSYNC();
        {   pg8::Gemm g{Ub, (const bf16*)(wl + WO_O), M, D, D}; pg8::StaticOrder S; S.init(M, D, G, vb);
            EpiRes E{(l == 0) ? (const void*)args.in[I_X] : (const void*)XB, XB, modl + 2 * D, (l == 0) ? 1 : 0};
            pg8::gemm_phase<EpiRes, pg8::StaticOrder, true, true>(lds, g, S, E); }
        GSYNC();
        { FRESH_TID();
        for (int m = vgw; m < M; m += NGW) { const float* mb = modl + (m >> 12) * (NMOD * D);
            norm_row_bf16in(XB + (size_t)m * D, Hb + (size_t)m * D, args.in[I_N2G] + l * D, mb + 3 * D, mb + 4 * D, lane); } }
        GSYNC();
        {   pg8::Gemm g{Hb, (const bf16*)(wl + WO_FI), M, CIN, D}; pg8::StaticOrder S; S.init(M, CIN, G, vb);
            EpiSwiglu E{HIDb};
            pg8::gemm_phase<EpiSwiglu, pg8::StaticOrder, true, true>(lds, g, S, E); }
        GSYNC();
        {   pg8::Gemm g{HIDb, (const bf16*)(wl + WO_FO), M, D, FFN}; pg8::StaticOrder S; S.init(M, D, G, vb);
            EpiRes E{(const void*)XB, XB, modl + 5 * D, 0};
            pg8::gemm_phase<EpiRes, pg8::StaticOrder, true, true>(lds, g, S, E); }
        GSYNC();
    }
    FRESH_TID();
    for (int m = vgw; m < M; m += NGW) final_norm_row(XB + (size_t)m * D, xout + (size_t)m * D, args.in[I_FG], lane);
}

extern "C" void kernel_launch(void* const* d_in, const int* in_sizes, int n_in, void* d_out, int out_size, void* d_ws, size_t ws_size, hipStream_t stream) {
    static int grid = 0;
    if (grid == 0) {
        if (n_in != 22 || in_sizes[0] != M * D || out_size != M * D || ws_size < WS_END) { fprintf(stderr, "kernel_launch: unexpected shapes (n_in %d, in0 %d, out %d, ws %zu); nothing launched\n", n_in, n_in > 0 ? in_sizes[0] : -1, out_size, ws_size); grid = -1; return; }
        int dev = 0, cus = 0, per_cu = 0;
        if (hipGetDevice(&dev) != hipSuccess || hipDeviceGetAttribute(&cus, hipDeviceAttributeMultiprocessorCount, dev) != hipSuccess) { grid = -1; return; }
        if (hipFuncSetAttribute((const void*)mk_fwd, hipFuncAttributeMaxDynamicSharedMemorySize, LDS_BYTES) != hipSuccess) { fprintf(stderr, "kernel_launch: hipFuncSetAttribute failed\n"); grid = -1; return; }
        if (hipOccupancyMaxActiveBlocksPerMultiprocessor(&per_cu, (const void*)mk_fwd, NWAVES * 64, LDS_BYTES) != hipSuccess || per_cu < 1) { fprintf(stderr, "kernel_launch: occupancy query gave %d\n", per_cu); per_cu = 1; }
        (void)hipGetLastError();
        grid = cus * per_cu;
    }
    if (grid < 0) return;
    Args a{};
    for (int i = 0; i < 22; ++i) a.in[i] = (const float*)d_in[i];
    a.out = (float*)d_out; a.ws = (unsigned char*)d_ws;
    if (hipMemsetAsync((char*)d_ws + WS_BAR, 0, BAR_ZERO_BYTES, stream) != hipSuccess) { fprintf(stderr, "kernel_launch: memset failed\n"); return; }
    void* kargs[] = {&a};
    hipError_t e = hipLaunchCooperativeKernel((const void*)mk_fwd, dim3(grid), dim3(NWAVES * 64), kargs, LDS_BYTES, stream);
    if (e != hipSuccess) fprintf(stderr, "kernel_launch: cooperative launch failed: %s (grid %d)\n", hipGetErrorString(e), grid);
}
```

```cpp
#include <hip/hip_runtime.h>
#include <hip/hip_cooperative_groups.h>
#include <cstdio>
#include <cstdint>
namespace cg = cooperative_groups;
namespace pg8 {
#define PG8_LAS __attribute__((address_space(3)))
typedef unsigned short bf16_t;
typedef short bf16x8 __attribute__((ext_vector_type(8)));
typedef float f32x4 __attribute__((ext_vector_type(4)));
typedef unsigned u32x4 __attribute__((ext_vector_type(4)));
constexpr int BM = 256, BK = 64, HALF = 128, HTB = HALF * BK * 2  , STAGE_BYTES = 8 * HTB, NXCD = 8, WGM = 8;

__host__ __device__ __forceinline__ int lds_byte(int r, int c) { const int st = (r >> 4) * 2 + (c >> 5), rr = r & 15, cc = c & 31, ob = rr * 64 + cc * 2; return st * 1024 + (ob ^ (((ob >> 9) & 1) << 5)); }
__host__ __device__ __forceinline__ void stage_rc(int b, int& R, int& C) { const int st = b / 1024, sb = b % 1024, swz = sb ^ (((sb >> 9) & 1) << 5); R = (st >> 1) * 16 + swz / 64; C = (st & 1) * 32 + (swz % 64) / 2; }
__host__ __device__ __forceinline__ int perm32(int rho) { const int n = rho >> 4, i = rho & 15; return 8 * (i >> 2) + 4 * n + (i & 3); }

struct Unit { int pm, pn; };
struct Gemm { const bf16_t* A; const bf16_t* Bt; int M, N, K; const bf16_t* A2 = nullptr; const bf16_t* Bt2 = nullptr; };

struct StaticOrder {
    int nM, nN, nwg, G, c;
    __host__ __device__ void init(int M, int N, int G_, int c_) { nM = M / BM; nN = N / BM; nwg = nM * nN; G = G_; c = c_; }
    __host__ __device__ bool next(int i, Unit& u) const {
        const long L = (long)i * G + c; if (L >= nwg) return false;
        int wgid = (int)L; { const int q = nwg / NXCD, r = nwg % NXCD, xcd = wgid % NXCD, off = wgid / NXCD; wgid = (xcd < r ? xcd * (q + 1) : r * (q + 1) + (xcd - r) * q) + off; }
        const int nig = WGM * nN, gid = wgid / nig, fm = gid * WGM, gsz = (nM - fm) < WGM ? (nM - fm) : WGM;
        u.pm = fm + ((wgid % nig) % gsz); u.pn = (wgid % nig) / gsz; return true;
    }
    __device__ __forceinline__ void a_ready(const Unit&) const {}
    __device__ __forceinline__ void done(const Unit&) const {}
};
__device__ __forceinline__ unsigned cvt_pk_bf16(float lo, float hi) { unsigned r; asm volatile("v_cvt_pk_bf16_f32 %0, %1, %2" : "=v"(r) : "v"(lo), "v"(hi)); return r; }
typedef float f32x2 __attribute__((ext_vector_type(2)));
template <class Epi, class Sched, bool ALIGN_EPI = false, bool SP2 = false>
__device__ __forceinline__ void gemm_phase(PG8_LAS unsigned char* lds, const Gemm g, const Sched& S, const Epi& E) {
    int tid_ = threadIdx.x; asm volatile("" : "+v"(tid_));
    const int tid = tid_, wid = __builtin_amdgcn_readfirstlane(tid >> 6), lane = tid & 63, wr = wid >> 2, wc = wid & 3, fr = lane & 15, fq = lane >> 4;
    const int K = g.K, nt1 = K / BK, nt = Epi::DUAL ? 2 * nt1 : nt1;
    unsigned voffA[2], voffB[2];
#pragma unroll
    for (int i = 0; i < 2; ++i) { int R, C; stage_rc(tid * 16 + i * 8192, R, C); const int Rb = Epi::PERM ? ((R & ~31) + perm32(R & 31)) : R;
        voffA[i] = (unsigned)(R * K + C) * 2u; voffB[i] = (unsigned)(Rb * K + C) * 2u; }
    const size_t kstep = (size_t)(BK * 2);
    const size_t hstep = (size_t)HALF * K * 2;
    const size_t tstep = 2 * hstep;
    const unsigned ldsw = (unsigned)wid * 1024u;
    const int aoff = lds_byte(wr * 64 + fr, fq * 8), boff = lds_byte(wc * 32 + fr, fq * 8);
#define PG8_SA(b, h) (((b) * 2 + (h)) * HTB)
#define PG8_SB(b, h) ((4 + (b) * 2 + (h)) * HTB)
#define PG8_STAGE(bufoff, gbase, voff) do { _Pragma("unroll") for (int _i = 0; _i < 2; ++_i) \
        __builtin_amdgcn_global_load_lds((const unsigned*)((const char*)(gbase) + (voff)[_i]), (PG8_LAS unsigned*)(lds + (bufoff) + ldsw + _i * 8192), 16, 0, 0); } while (0)
#define PG8_LDA(dst, b, h) do { _Pragma("unroll") for (int m = 0; m < 4; ++m) _Pragma("unroll") for (int k = 0; k < 2; ++k) dst[m][k] = *(const PG8_LAS bf16x8*)(lds + PG8_SA(b, h) + aoff + m * 2048 + k * 1024); } while (0)
#define PG8_LDB(dst, b, h) do { _Pragma("unroll") for (int n = 0; n < 2; ++n) _Pragma("unroll") for (int k = 0; k < 2; ++k) dst[n][k] = *(const PG8_LAS bf16x8*)(lds + PG8_SB(b, h) + boff + n * 2048 + k * 1024); } while (0)
#define PG8_MMA(ai, bj, At, Bt) do { __builtin_amdgcn_s_setprio(1); _Pragma("unroll") for (int m = 0; m < 4; ++m) _Pragma("unroll") for (int n = 0; n < 2; ++n) _Pragma("unroll") for (int k = 0; k < 2; ++k) \
        acc[ai][bj][m][n] = __builtin_amdgcn_mfma_f32_16x16x32_bf16(Bt[n][k], At[m][k], acc[ai][bj][m][n], 0, 0, 0); __builtin_amdgcn_s_setprio(0); } while (0)
#define PG8_WAIT_V(n) asm volatile("s_waitcnt vmcnt(" #n ")" ::: "memory")
#define PG8_WAIT_L(n) asm volatile("s_waitcnt lgkmcnt(" #n ")" ::: "memory")
#define PG8_BAR __builtin_amdgcn_s_barrier()
#define PG8_SCHED __builtin_amdgcn_sched_barrier(0)
    Unit cur, nxt; int ui = 0;
    if (!S.next(0, cur)) return;
    f32x4 acc[2][2][4][2];
#pragma unroll
    for (int a = 0; a < 2; ++a)
#pragma unroll
        for (int b = 0; b < 2; ++b)
#pragma unroll
            for (int m = 0; m < 4; ++m)
#pragma unroll
                for (int n = 0; n < 2; ++n) acc[a][b][m][n] = (f32x4){0.f, 0.f, 0.f, 0.f};
    bf16x8 At[4][2], B0[2][2], B1[2][2];
    const char* cA = (const char*)g.A + (size_t)cur.pm * tstep; const char* cB = (const char*)g.Bt + (size_t)cur.pn * tstep;
    const char* cA2 = Epi::DUAL ? (const char*)g.A2 + (size_t)cur.pm * tstep : cA; const char* cB2 = Epi::DUAL ? (const char*)g.Bt2 + (size_t)cur.pn * tstep : cB;
    S.a_ready(cur);
    if constexpr (SP2) {
        PG8_STAGE(PG8_SB(0, 0), cB, voffB); PG8_STAGE(PG8_SB(0, 1), cB + hstep, voffB); PG8_STAGE(PG8_SA(0, 0), cA, voffA); PG8_STAGE(PG8_SA(0, 1), cA + hstep, voffA);
        if (wr == 1) PG8_BAR;
        PG8_WAIT_V(2); PG8_BAR;
        PG8_STAGE(PG8_SB(1, 0), cB + kstep, voffB); PG8_STAGE(PG8_SA(1, 0), cA + kstep, voffA); PG8_STAGE(PG8_SB(1, 1), cB + hstep + kstep, voffB);
        PG8_WAIT_V(6); PG8_BAR;
    } else {
        PG8_STAGE(PG8_SB(0, 0), cB, voffB); PG8_STAGE(PG8_SA(0, 0), cA, voffA); PG8_STAGE(PG8_SB(0, 1), cB + hstep, voffB); PG8_STAGE(PG8_SA(0, 1), cA + hstep, voffA);
        if (wr == 1) PG8_BAR;
        PG8_WAIT_V(4); PG8_BAR;
        PG8_STAGE(PG8_SB(1, 0), cB + kstep, voffB); PG8_STAGE(PG8_SA(1, 0), cA + kstep, voffA); PG8_STAGE(PG8_SB(1, 1), cB + hstep + kstep, voffB);
        PG8_WAIT_V(6); PG8_BAR;
    }
    for (;;) {
        const bool has_next = S.next(ui + 1, nxt);
        const char* nA = has_next ? (const char*)g.A + (size_t)nxt.pm * tstep : cA; const char* nB = has_next ? (const char*)g.Bt + (size_t)nxt.pn * tstep : cB;
        for (int t = 0; t < nt; t += 2) {
            const bool last = (t == nt - 2);
            const char* tA1 = cA + (size_t)(t + 1) * kstep; const char* tA2 = cA + (size_t)(t + 2) * kstep; const char* tB2 = cB + (size_t)(t + 2) * kstep;
            if constexpr (Epi::DUAL) {
                if (t >= nt1) tA1 = cA2 + (size_t)(t + 1 - nt1) * kstep;
                if (t + 2 >= nt1) { tA2 = cA2 + (size_t)(t + 2 - nt1) * kstep; tB2 = cB2 + (size_t)(t + 2 - nt1) * kstep; }
                if (t == nt1) { int fr_m = fr, fq_m = fq; asm volatile("" : "+v"(fr_m), "+v"(fq_m)); E.mid(acc, cur, wr, wc, fr_m, fq_m); }
            }
            const char* a1 = tA1;
            const char* a2 = last ? nA : tA2; const char* b2 = last ? nB : tB2;
            const char* a3 = a2 + kstep; const char* b3 = b2 + kstep;
            if (last && has_next) S.a_ready(nxt);
            if constexpr (SP2) {
            PG8_LDB(B0, 0, 0); PG8_LDB(B1, 0, 1); PG8_SCHED; PG8_LDA(At, 0, 0); PG8_STAGE(PG8_SA(1, 1), a1 + hstep, voffA);
            PG8_WAIT_V(8); PG8_WAIT_L(0); PG8_BAR; PG8_MMA(0, 0, At, B0); PG8_MMA(0, 1, At, B1); PG8_BAR; PG8_SCHED;
            PG8_LDA(At, 0, 1); PG8_STAGE(PG8_SB(0, 0), b2, voffB); PG8_STAGE(PG8_SB(0, 1), b2 + hstep, voffB); PG8_STAGE(PG8_SA(0, 0), a2, voffA);
            PG8_WAIT_V(8); PG8_WAIT_L(0); PG8_BAR; PG8_MMA(1, 0, At, B0); PG8_MMA(1, 1, At, B1); PG8_BAR; PG8_SCHED;
            PG8_LDB(B0, 1, 0); PG8_LDB(B1, 1, 1); PG8_SCHED; PG8_LDA(At, 1, 0); PG8_STAGE(PG8_SA(0, 1), a2 + hstep, voffA);
            PG8_WAIT_V(8); PG8_WAIT_L(0); PG8_BAR; PG8_MMA(0, 0, At, B0); PG8_MMA(0, 1, At, B1); PG8_BAR; PG8_SCHED;
            PG8_LDA(At, 1, 1); PG8_STAGE(PG8_SB(1, 0), b3, voffB); PG8_STAGE(PG8_SB(1, 1), b3 + hstep, voffB); PG8_STAGE(PG8_SA(1, 0), a3, voffA);
            PG8_WAIT_V(8); PG8_WAIT_L(0); PG8_BAR; PG8_MMA(1, 0, At, B0); PG8_MMA(1, 1, At, B1); PG8_BAR; PG8_SCHED;
            } else {
            PG8_LDB(B0, 0, 0); PG8_SCHED; PG8_LDA(At, 0, 0); PG8_STAGE(PG8_SA(1, 1), a1 + hstep, voffA);
            PG8_WAIT_L(8); PG8_BAR; PG8_WAIT_L(0); PG8_MMA(0, 0, At, B0); PG8_BAR; PG8_SCHED;
            PG8_LDB(B1, 0, 1); PG8_STAGE(PG8_SB(0, 0), b2, voffB);
            PG8_BAR; PG8_WAIT_L(0); PG8_MMA(0, 1, At, B1); PG8_BAR;
            PG8_LDA(At, 0, 1); PG8_STAGE(PG8_SA(0, 0), a2, voffA);
            PG8_BAR; PG8_WAIT_L(0); PG8_MMA(1, 0, At, B0); PG8_BAR; PG8_SCHED;
            PG8_STAGE(PG8_SB(0, 1), b2 + hstep, voffB);
            PG8_WAIT_V(6); PG8_BAR; PG8_MMA(1, 1, At, B1); PG8_BAR;
            PG8_LDB(B0, 1, 0); PG8_SCHED; PG8_LDA(At, 1, 0); PG8_STAGE(PG8_SA(0, 1), a2 + hstep, voffA);
            PG8_WAIT_L(8); PG8_BAR; PG8_WAIT_L(0); PG8_MMA(0, 0, At, B0); PG8_BAR; PG8_SCHED;
            PG8_LDB(B1, 1, 1); PG8_STAGE(PG8_SB(1, 0), b3, voffB);
            PG8_BAR; PG8_WAIT_L(0); PG8_MMA(0, 1, At, B1); PG8_BAR;
            PG8_LDA(At, 1, 1); PG8_STAGE(PG8_SA(1, 0), a3, voffA);
            PG8_BAR; PG8_WAIT_L(0); PG8_MMA(1, 0, At, B0); PG8_BAR; PG8_SCHED;
            PG8_STAGE(PG8_SB(1, 1), b3 + hstep, voffB);
            PG8_WAIT_V(6); PG8_BAR; PG8_MMA(1, 1, At, B1); PG8_BAR;
            }
        }
        if constexpr (ALIGN_EPI) { if (wr == 0) PG8_BAR; }
        if constexpr (!Epi::AFTER_DRAIN) { int fr_e = fr, fq_e = fq; asm volatile("" : "+v"(fr_e), "+v"(fq_e)); E(acc, cur, wr, wc, fr_e, fq_e); S.done(cur); }
        if (!has_next) break;
#pragma unroll
        for (int a = 0; a < 2; ++a)
#pragma unroll
            for (int b = 0; b < 2; ++b)
#pragma unroll
                for (int m = 0; m < 4; ++m)
#pragma unroll
                    for (int n = 0; n < 2; ++n) acc[a][b][m][n] = (f32x4){0.f, 0.f, 0.f, 0.f};
        cur = nxt; cA = nA; cB = nB; ++ui;
        if constexpr (Epi::DUAL) { cA2 = (const char*)g.A2 + (size_t)cur.pm * tstep; cB2 = (const char*)g.Bt2 + (size_t)cur.pn * tstep; }
        if constexpr (ALIGN_EPI) { if (wr == 1) PG8_BAR; }
    }
    PG8_WAIT_V(0);
    if constexpr (!ALIGN_EPI) { if (wr == 0) PG8_BAR; }
    PG8_BAR;
    if constexpr (Epi::AFTER_DRAIN) { E.fused(acc, cur, wr, wc, fr, fq, lds, wid, lane); S.done(cur); }
#undef PG8_SA
#undef PG8_SB
#undef PG8_STAGE
#undef PG8_LDA
#undef PG8_LDB
#undef PG8_MMA
#undef PG8_WAIT_V
#undef PG8_WAIT_L
#undef PG8_BAR
#undef PG8_SCHED
}
}

constexpr int NWAVES = 8;
constexpr int D = 2048, SEQ = 4096, NB = 4, M = NB * SEQ, CIN = 11264, FFN = 5632, NMOD = 6, DEPTH = 2;
constexpr float EPS = 1e-6f, LOG2E = 1.4426950408889634f;
constexpr float SC2 = 0.08838834764831845f * 1.4426950408889634f;

constexpr size_t MiB = 1u << 20;
constexpr size_t WS_BAR = 0, BAR_ZERO_BYTES = 16384;
constexpr size_t WS_MODP = 2 * MiB;
constexpr size_t WS_MOD = 9 * MiB;
constexpr size_t WS_W = 16 * MiB, W_LAYER = 135 * MiB;
constexpr size_t WO_IN = 0, WO_LO = 44 * MiB, WO_AO = 52 * MiB, WO_O = 60 * MiB, WO_FI = 68 * MiB, WO_FO = 112 * MiB, WO_WA = 134 * MiB, WO_WX = 134 * MiB + 512 * 1024;
constexpr size_t WS_H = 288 * MiB;
constexpr size_t WS_U = 352 * MiB, WS_LG = 416 * MiB, WS_Q = 480 * MiB, WS_K = 544 * MiB, WS_VT = 560 * MiB, WS_MG = 576 * MiB;
constexpr size_t WS_HID = 352 * MiB;
constexpr size_t WS_XB = 704 * MiB;
constexpr size_t WS_END = 768 * MiB;
constexpr int LDS_BYTES = 155648;

#define GAS __attribute__((address_space(1)))
#define LAS __attribute__((address_space(3)))
typedef unsigned short bf16;
typedef unsigned v4u __attribute__((ext_vector_type(4)));
typedef unsigned v2u __attribute__((ext_vector_type(2)));
typedef float f32x4 __attribute__((ext_vector_type(4)));
typedef float f32x16 __attribute__((ext_vector_type(16)));
typedef short bf16x8 __attribute__((ext_vector_type(8)));
typedef short s16x4 __attribute__((ext_vector_type(4)));
typedef short v4i16_t __attribute__((ext_vector_type(4)));
typedef __bf16 bf16x2_t __attribute__((ext_vector_type(2)));
typedef float f32x2_t __attribute__((ext_vector_type(2)));
#define LDS_WAIT() asm volatile("s_waitcnt lgkmcnt(0)" ::: "memory")

__device__ __forceinline__ unsigned pk2(float lo, float hi) { f32x2_t v = {lo, hi}; bf16x2_t b = __builtin_convertvector(v, bf16x2_t); return __builtin_bit_cast(unsigned, b); }
__device__ __forceinline__ float bflo(unsigned w) { return __builtin_bit_cast(float, w << 16); }
__device__ __forceinline__ float bfhi(unsigned w) { return __builtin_bit_cast(float, w & 0xffff0000u); }
__device__ __forceinline__ float bf2f(bf16 b) { return __builtin_bit_cast(float, ((unsigned)b) << 16); }
__device__ __forceinline__ float sigmoid_f(float v) { return __builtin_amdgcn_rcpf(1.0f + __builtin_amdgcn_exp2f(-v * LOG2E)); }
__device__ __forceinline__ float gelu_tanh_f(float v) { const float z = 1.5957691216057308f * (v + 0.044715f * v * v * v); return v * sigmoid_f(z); }
__device__ __forceinline__ float wave_sum(float v) {
#pragma unroll
    for (int o = 1; o < 64; o <<= 1) v += __shfl_xor(v, o);
    return v;
}

using pg8::Unit; using pg8::bf16_t;
struct EpiIn {
    static constexpr bool PERM = true, AFTER_DRAIN = false, DUAL = false;
    const float* bias; bf16* U; bf16* LG; bf16* Q; bf16* Kb; bf16* Vt; bf16* MG;
    template <int MODE> __device__ __forceinline__ void body(const f32x4 (&acc)[2][2][4][2], bf16* base, int ldc, int c0, int row0, int lc, const f32x4 (&bv)[2][2]) const {
#pragma unroll
        for (int ai = 0; ai < 2; ++ai)
#pragma unroll
            for (int m = 0; m < 4; ++m) {
                const int row = row0 + ai * 128 + m * 16;
#pragma unroll
                for (int bj = 0; bj < 2; ++bj) {
                    f32x4 v0 = acc[ai][bj][m][0] + bv[bj][0], v1 = acc[ai][bj][m][1] + bv[bj][1];
                    if (MODE == 1) {
#pragma unroll
                        for (int j = 0; j < 4; ++j) { v0[j] = gelu_tanh_f(v0[j]); v1[j] = gelu_tanh_f(v1[j]); }
                    } else if (MODE == 2) {
#pragma unroll
                        for (int j = 0; j < 4; ++j) { v0[j] = sigmoid_f(v0[j]); v1[j] = sigmoid_f(v1[j]); }
                    }
                    v4u w; w.x = pk2(v0[0], v0[1]); w.y = pk2(v0[2], v0[3]); w.z = pk2(v1[0], v1[1]); w.w = pk2(v1[2], v1[3]);
                    if (MODE != 3) {
                        *(v4u*)(base + (size_t)row * ldc + c0 + bj * 128 + lc) = w;
                    } else {
                        const int b = row >> 12, s = row & 4095, cv = c0 + bj * 128 + lc;
                        bf16* p = base + (((size_t)(b * 512 + cv)) << 12) + s;
                        p[0 << 12] = (bf16)(w.x & 0xffffu); p[1 << 12] = (bf16)(w.x >> 16);
                        p[2 << 12] = (bf16)(w.y & 0xffffu); p[3 << 12] = (bf16)(w.y >> 16);
                        p[4 << 12] = (bf16)(w.z & 0xffffu); p[5 << 12] = (bf16)(w.z >> 16);
                        p[6 << 12] = (bf16)(w.w & 0xffffu); p[7 << 12] = (bf16)(w.w >> 16);
                    }
                }
            }
    }
    __device__ __forceinline__ void body_mix(const f32x4 (&acc)[2][2][4][2], int t, int row0, int lc, const f32x4 (&bv)[2][2]) const {
#pragma unroll
        for (int ai = 0; ai < 2; ++ai)
#pragma unroll
            for (int m = 0; m < 4; ++m) {
                const int row = row0 + ai * 128 + m * 16;
                float rt[8], sb[8];
#pragma unroll
                for (int n = 0; n < 2; ++n)
#pragma unroll
                    for (int j = 0; j < 4; ++j) {
                        const float a = acc[ai][0][m][n][j] + bv[0][n][j], b = acc[ai][1][m][n][j] + bv[1][n][j];
                        const float ea = __builtin_amdgcn_exp2f(-a * LOG2E), eb = __builtin_amdgcn_exp2f(-b * LOG2E);
                        sb[4 * n + j] = __builtin_amdgcn_rcpf(1.0f + eb);
                        rt[4 * n + j] = (1.0f + eb) * __builtin_amdgcn_rcpf(1.0f + ea);
                    }
                v4u w0, w1;
                w0.x = pk2(rt[0], rt[1]); w0.y = pk2(rt[2], rt[3]); w0.z = pk2(rt[4], rt[5]); w0.w = pk2(rt[6], rt[7]);
                w1.x = pk2(sb[0], sb[1]); w1.y = pk2(sb[2], sb[3]); w1.z = pk2(sb[4], sb[5]); w1.w = pk2(sb[6], sb[7]);
                bf16* p = MG + (size_t)row * 4096 + 128 * t + lc;
                *(v4u*)p = w0; *(v4u*)(p + 2048) = w1;
            }
    }
    __device__ __forceinline__ void operator()(const f32x4 (&acc)[2][2][4][2], const Unit& u, int wr, int wc, int fr, int fq) const {
        const int colt = u.pn * 256;
        const int row0 = u.pm * 256 + wr * 64 + fr, lc = wc * 32 + 8 * fq;
        f32x4 bv[2][2];
        if (colt >= 7168) {
            const int t = (colt - 7168) >> 8;
#pragma unroll
            for (int n = 0; n < 2; ++n) { bv[0][n] = *(const f32x4*)(bias + 7168 + 128 * t + lc + 4 * n); bv[1][n] = *(const f32x4*)(bias + 7168 + D + 128 * t + lc + 4 * n); }
            body_mix(acc, t, row0, lc, bv);
            return;
        }
#pragma unroll
        for (int bj = 0; bj < 2; ++bj)
#pragma unroll
            for (int n = 0; n < 2; ++n) bv[bj][n] = *(const f32x4*)(bias + colt + lc + bj * 128 + 4 * n);
        int mode, ldc, c0; bf16* base;
        if (colt < 2048)      { mode = 0; base = U;  ldc = 2048; c0 = colt; }
        else if (colt < 4096) { mode = 1; base = LG; ldc = 2048; c0 = colt - 2048; }
        else if (colt < 6144) { mode = 0; base = Q;  ldc = 2048; c0 = colt - 4096; }
        else if (colt < 6656) { mode = 0; base = Kb; ldc = 512;  c0 = colt - 6144; }
        else                  { mode = 0; base = Vt; ldc = 512;  c0 = colt - 6656; }
        if (mode == 0) body<0>(acc, base, ldc, c0, row0, lc, bv);
        else body<1>(acc, base, ldc, c0, row0, lc, bv);
    }
};
struct EpiMerge {
    static constexpr bool PERM = true, AFTER_DRAIN = false, DUAL = true;
    const bf16* MG; bf16* OUT;
    __device__ __forceinline__ void mid(f32x4 (&acc)[2][2][4][2], const Unit& u, int wr, int wc, int fr, int fq) const {
        const int row0 = u.pm * 256 + wr * 64 + fr, col0 = u.pn * 256 + wc * 32 + 8 * fq;
#pragma unroll
        for (int ai = 0; ai < 2; ++ai) {
            v4u gg[8];
#pragma unroll
            for (int m = 0; m < 4; ++m)
#pragma unroll
                for (int bj = 0; bj < 2; ++bj) gg[2 * m + bj] = *(const v4u*)(MG + (size_t)(row0 + ai * 128 + m * 16) * 4096 + col0 + bj * 128);
            asm volatile("" : "+v"(gg[0]), "+v"(gg[1]), "+v"(gg[2]), "+v"(gg[3]), "+v"(gg[4]), "+v"(gg[5]), "+v"(gg[6]), "+v"(gg[7]));
#pragma unroll
            for (int m = 0; m < 4; ++m)
#pragma unroll
                for (int bj = 0; bj < 2; ++bj) { const v4u g = gg[2 * m + bj];
                    f32x4 r0, r1;
                    r0[0] = bflo(g.x); r0[1] = bfhi(g.x); r0[2] = bflo(g.y); r0[3] = bfhi(g.y); r1[0] = bflo(g.z); r1[1] = bfhi(g.z); r1[2] = bflo(g.w); r1[3] = bfhi(g.w);
                    acc[ai][bj][m][0] *= r0; acc[ai][bj][m][1] *= r1; }
        }
    }
    __device__ __forceinline__ void operator()(const f32x4 (&acc)[2][2][4][2], const Unit& u, int wr, int wc, int fr, int fq) const {
        const int row0 = u.pm * 256 + wr * 64 + fr, col0 = u.pn * 256 + wc * 32 + 8 * fq;
#pragma unroll
        for (int ai = 0; ai < 2; ++ai) {
            v4u g[4][2];
#pragma unroll
            for (int m = 0; m < 4; ++m)
#pragma unroll
                for (int bj = 0; bj < 2; ++bj) g[m][bj] = *(const v4u*)(MG + (size_t)(row0 + ai * 128 + m * 16) * 4096 + 2048 + col0 + bj * 128);
            asm volatile("" : "+v"(g[0][0]), "+v"(g[0][1]), "+v"(g[1][0]), "+v"(g[1][1]), "+v"(g[2][0]), "+v"(g[2][1]), "+v"(g[3][0]), "+v"(g[3][1]));
#pragma unroll
            for (int m = 0; m < 4; ++m)
#pragma unroll
                for (int bj = 0; bj < 2; ++bj) {
                    const v4u gg = g[m][bj];
                    f32x4 v0 = acc[ai][bj][m][0], v1 = acc[ai][bj][m][1];
                    v0[0] *= bflo(gg.x); v0[1] *= bfhi(gg.x); v0[2] *= bflo(gg.y); v0[3] *= bfhi(gg.y);
                    v1[0] *= bflo(gg.z); v1[1] *= bfhi(gg.z); v1[2] *= bflo(gg.w); v1[3] *= bfhi(gg.w);
                    v4u w; w.x = pk2(v0[0], v0[1]); w.y = pk2(v0[2], v0[3]); w.z = pk2(v1[0], v1[1]); w.w = pk2(v1[2], v1[3]);
                    *(v4u*)(OUT + (size_t)(row0 + ai * 128 + m * 16) * 2048 + col0 + bj * 128) = w;
                }
        }
    }
};
struct EpiRes {
    static constexpr bool PERM = true, AFTER_DRAIN = false, DUAL = false;
    const void* src; bf16* dst; const float* gvec; int src_f32;
    __device__ __forceinline__ void operator()(const f32x4 (&acc)[2][2][4][2], const Unit& u, int wr, int wc, int fr, int fq) const {
        const int row0 = u.pm * 256 + wr * 64 + fr, col0 = u.pn * 256 + wc * 32 + 8 * fq;
        const float* g = gvec + (u.pm >> 4) * (NMOD * D);
        f32x4 gv[2][2];
#pragma unroll
        for (int bj = 0; bj < 2; ++bj)
#pragma unroll
            for (int n = 0; n < 2; ++n) gv[bj][n] = *(const f32x4*)(g + col0 + bj * 128 + 4 * n);
        if (src_f32) {
            const float* s = (const float*)src;
#pragma unroll
            for (int ai = 0; ai < 2; ++ai)
#pragma unroll
                for (int mh = 0; mh < 2; ++mh) {
                    f32x4 xs[2][2][2];
#pragma unroll
                    for (int mm = 0; mm < 2; ++mm)
#pragma unroll
                        for (int bj = 0; bj < 2; ++bj)
#pragma unroll
                            for (int n = 0; n < 2; ++n) xs[mm][bj][n] = *(const f32x4*)(s + (size_t)(row0 + ai * 128 + (2 * mh + mm) * 16) * D + col0 + bj * 128 + 4 * n);
                    asm volatile("" : "+v"(xs[0][0][0]), "+v"(xs[0][0][1]), "+v"(xs[0][1][0]), "+v"(xs[0][1][1]), "+v"(xs[1][0][0]), "+v"(xs[1][0][1]), "+v"(xs[1][1][0]), "+v"(xs[1][1][1]));
#pragma unroll
                    for (int mm = 0; mm < 2; ++mm)
#pragma unroll
                        for (int bj = 0; bj < 2; ++bj) { const int m = 2 * mh + mm;
                            const f32x4 x0 = xs[mm][bj][0] + gv[bj][0] * acc[ai][bj][m][0], x1 = xs[mm][bj][1] + gv[bj][1] * acc[ai][bj][m][1];
                            v4u w; w.x = pk2(x0[0], x0[1]); w.y = pk2(x0[2], x0[3]); w.z = pk2(x1[0], x1[1]); w.w = pk2(x1[2], x1[3]);
                            *(v4u*)(dst + (size_t)(row0 + ai * 128 + m * 16) * D + col0 + bj * 128) = w; }
                }
        } else {
            const bf16* s = (const bf16*)src;
#pragma unroll
            for (int ai = 0; ai < 2; ++ai) {
                v4u xs[4][2];
#pragma unroll
                for (int m = 0; m < 4; ++m)
#pragma unroll
                    for (int bj = 0; bj < 2; ++bj) xs[m][bj] = *(const v4u*)(s + (size_t)(row0 + ai * 128 + m * 16) * D + col0 + bj * 128);
                asm volatile("" : "+v"(xs[0][0]), "+v"(xs[0][1]), "+v"(xs[1][0]), "+v"(xs[1][1]), "+v"(xs[2][0]), "+v"(xs[2][1]), "+v"(xs[3][0]), "+v"(xs[3][1]));
#pragma unroll
                for (int m = 0; m < 4; ++m)
#pragma unroll
                    for (int bj = 0; bj < 2; ++bj) { const v4u t = xs[m][bj];
                        f32x4 x0, x1;
                        x0[0] = bflo(t.x); x0[1] = bfhi(t.x); x0[2] = bflo(t.y); x0[3] = bfhi(t.y); x1[0] = bflo(t.z); x1[1] = bfhi(t.z); x1[2] = bflo(t.w); x1[3] = bfhi(t.w);
                        x0 += gv[bj][0] * acc[ai][bj][m][0]; x1 += gv[bj][1] * acc[ai][bj][m][1];
                        v4u w; w.x = pk2(x0[0], x0[1]); w.y = pk2(x0[2], x0[3]); w.z = pk2(x1[0], x1[1]); w.w = pk2(x1[2], x1[3]);
                        *(v4u*)(dst + (size_t)(row0 + ai * 128 + m * 16) * D + col0 + bj * 128) = w; }
            }
        }
    }
};
struct EpiSwiglu {
    static constexpr bool PERM = true, AFTER_DRAIN = false, DUAL = false;
    bf16* HID;
    __device__ __forceinline__ void operator()(const f32x4 (&acc)[2][2][4][2], const Unit& u, int wr, int wc, int fr, int fq) const {
        const int row0 = u.pm * 256 + wr * 64 + fr, col0 = u.pn * 128 + wc * 32 + 8 * fq;
#pragma unroll
        for (int ai = 0; ai < 2; ++ai)
#pragma unroll
            for (int m = 0; m < 4; ++m) {
                f32x4 o0, o1;
#pragma unroll
                for (int j = 0; j < 4; ++j) { const float g0 = acc[ai][0][m][0][j], g1 = acc[ai][0][m][1][j];
                    o0[j] = g0 * sigmoid_f(g0) * acc[ai][1][m][0][j]; o1[j] = g1 * sigmoid_f(g1) * acc[ai][1][m][1][j]; }
                v4u w; w.x = pk2(o0[0], o0[1]); w.y = pk2(o0[2], o0[3]); w.z = pk2(o1[0], o1[1]); w.w = pk2(o1[2], o1[3]);
                *(v4u*)(HID + (size_t)(row0 + ai * 128 + m * 16) * FFN + col0) = w;
            }
    }
};


__device__ __forceinline__ void transpose_item(const float* W, int K, int N, bf16* WT, int k0, int n0, int drow0, LAS float* scr, int lane) {
#pragma unroll 8
    for (int i = 0; i < 32; ++i) { const int kk = 2 * i + (lane >> 5); scr[kk * 33 + (lane & 31)] = W[(size_t)(k0 + kk) * N + n0 + (lane & 31)]; }
    LDS_WAIT(); asm volatile("" ::: "memory");
    const int c = lane & 7;
#pragma unroll
    for (int j = 0; j < 4; ++j) { const int n = (lane >> 3) + 8 * j; const LAS float* s = scr + (8 * c) * 33 + n;
        v4u o; o.x = pk2(s[0 * 33], s[1 * 33]); o.y = pk2(s[2 * 33], s[3 * 33]); o.z = pk2(s[4 * 33], s[5 * 33]); o.w = pk2(s[6 * 33], s[7 * 33]);
        *(v4u*)(WT + (size_t)(drow0 + n) * K + k0 + 8 * c) = o; }
    LDS_WAIT(); asm volatile("" ::: "memory");
}
__device__ __forceinline__ void transpose_mat(const float* W, int K, int N, bf16* WT, int item, LAS float* scr, int lane, int perm) {
    const int nblk = N / 32, kb = item / nblk, nb = item % nblk, n0 = 32 * nb;
    int drow0 = n0;
    if (perm == 1) { drow0 = (n0 < FFN) ? 256 * (n0 >> 7) + (n0 & 127) : 256 * ((n0 - FFN) >> 7) + 128 + ((n0 - FFN) & 127); }
    if (perm == 2 && n0 >= 7168) { const int c = n0 - 7168;
        drow0 = (c < D) ? 7168 + 256 * (c >> 7) + (c & 127) : 7168 + 256 * ((c - D) >> 7) + 128 + ((c - D) & 127); }
    transpose_item(W, K, N, WT, 64 * kb, n0, drow0, scr, lane);
}

__device__ __forceinline__ void norm_row_bf16(const float* xrow, bf16* orow, const float* g, const float* shift, const float* scale, int lane) {
    const f32x4* xr = (const f32x4*)xrow + lane;
    f32x4 v[8]; float s = 0.f;
#pragma unroll
    for (int j = 0; j < 8; ++j) { v[j] = xr[64 * j]; s += (v[j].x * v[j].x + v[j].y * v[j].y) + (v[j].z * v[j].z + v[j].w * v[j].w); }
    const float inv = 1.0f / sqrtf(wave_sum(s) * (1.f / D) + EPS);
    v2u* o8 = (v2u*)orow + lane;
#pragma unroll
    for (int j = 0; j < 8; ++j) {
        const f32x4 gg = ((const f32x4*)g)[lane + 64 * j], sh = ((const f32x4*)shift)[lane + 64 * j], sc = ((const f32x4*)scale)[lane + 64 * j];
        const f32x4 hh = (v[j] * inv) * gg * (sc + 1.0f) + sh;
        v2u w; w.x = pk2(hh.x, hh.y); w.y = pk2(hh.z, hh.w); o8[64 * j] = w;
    }
}
__device__ __forceinline__ void norm_row_bf16in(const bf16* xrow, bf16* orow, const float* g, const float* shift, const float* scale, int lane) {
    const v4u* xr = (const v4u*)xrow + lane;
    float v[4][8]; float s = 0.f;
#pragma unroll
    for (int j = 0; j < 4; ++j) { const v4u t = xr[64 * j];
        v[j][0] = bflo(t.x); v[j][1] = bfhi(t.x); v[j][2] = bflo(t.y); v[j][3] = bfhi(t.y); v[j][4] = bflo(t.z); v[j][5] = bfhi(t.z); v[j][6] = bflo(t.w); v[j][7] = bfhi(t.w);
#pragma unroll
        for (int e = 0; e < 8; ++e) s += v[j][e] * v[j][e]; }
    const float inv = 1.0f / sqrtf(wave_sum(s) * (1.f / D) + EPS);
    v4u* o16 = (v4u*)orow + lane;
#pragma unroll
    for (int j = 0; j < 4; ++j) {
        float hh[8];
#pragma unroll
        for (int q = 0; q < 2; ++q) {
            const f32x4 gg = ((const f32x4*)g)[2 * lane + 128 * j + q], sh = ((const f32x4*)shift)[2 * lane + 128 * j + q], sc = ((const f32x4*)scale)[2 * lane + 128 * j + q];
#pragma unroll
            for (int e = 0; e < 4; ++e) hh[4 * q + e] = (v[j][4 * q + e] * inv) * gg[e] * (sc[e] + 1.0f) + sh[e];
        }
        v4u w; w.x = pk2(hh[0], hh[1]); w.y = pk2(hh[2], hh[3]); w.z = pk2(hh[4], hh[5]); w.w = pk2(hh[6], hh[7]); o16[64 * j] = w;
    }
}
__device__ __forceinline__ void norm_1row_from(const v4u (&tt)[4], bf16* orow, const float* g, const float* shift, const float* scale, int lane) {
    float s = 0.f;
#pragma unroll
    for (int j = 0; j < 4; ++j) { const v4u t = tt[j];
        const float a0 = bflo(t.x), a1 = bfhi(t.x), a2 = bflo(t.y), a3 = bfhi(t.y), a4 = bflo(t.z), a5 = bfhi(t.z), a6 = bflo(t.w), a7 = bfhi(t.w);
        s += (a0 * a0 + a1 * a1) + (a2 * a2 + a3 * a3) + (a4 * a4 + a5 * a5) + (a6 * a6 + a7 * a7); }
    const float inv = 1.0f / sqrtf(wave_sum(s) * (1.f / D) + EPS);
    v4u* o16 = (v4u*)orow + lane;
#pragma unroll
    for (int j = 0; j < 4; ++j) { const v4u t = tt[j];
        const float x[8] = {bflo(t.x), bfhi(t.x), bflo(t.y), bfhi(t.y), bflo(t.z), bfhi(t.z), bflo(t.w), bfhi(t.w)};
        float hh[8];
#pragma unroll
        for (int q = 0; q < 2; ++q) {
            const f32x4 gg = ((const f32x4*)g)[2 * lane + 128 * j + q], sh = ((const f32x4*)shift)[2 * lane + 128 * j + q], sc = ((const f32x4*)scale)[2 * lane + 128 * j + q];
#pragma unroll
            for (int e = 0; e < 4; ++e) hh[4 * q + e] = (x[4 * q + e] * inv) * gg[e] * (sc[e] + 1.0f) + sh[e];
        }
        v4u w; w.x = pk2(hh[0], hh[1]); w.y = pk2(hh[2], hh[3]); w.z = pk2(hh[4], hh[5]); w.w = pk2(hh[6], hh[7]); o16[64 * j] = w;
    }
}
__device__ __forceinline__ void norm_2rows_bf16in(const bf16* x1, const bf16* x2, bf16* o1, bf16* o2, const float* g, const float* sh1, const float* sc1, const float* sh2, const float* sc2, int lane) {
    v4u t[8];
#pragma unroll
    for (int j = 0; j < 4; ++j) { t[j] = ((const v4u*)x1 + lane)[64 * j]; t[4 + j] = ((const v4u*)x2 + lane)[64 * j]; }
    asm volatile("" : "+v"(t[0]), "+v"(t[1]), "+v"(t[2]), "+v"(t[3]), "+v"(t[4]), "+v"(t[5]), "+v"(t[6]), "+v"(t[7]));
    const v4u ta[4] = {t[0], t[1], t[2], t[3]}; const v4u tb[4] = {t[4], t[5], t[6], t[7]};
    norm_1row_from(ta, o1, g, sh1, sc1, lane);
    norm_1row_from(tb, o2, g, sh2, sc2, lane);
}
__device__ __forceinline__ void final_norm_row(const bf16* xrow, float* orow, const float* g, int lane) {
    const v4u* xr = (const v4u*)xrow + lane;
    float v[4][8]; float s = 0.f;
#pragma unroll
    for (int j = 0; j < 4; ++j) { const v4u t = xr[64 * j];
        v[j][0] = bflo(t.x); v[j][1] = bfhi(t.x); v[j][2] = bflo(t.y); v[j][3] = bfhi(t.y); v[j][4] = bflo(t.z); v[j][5] = bfhi(t.z); v[j][6] = bflo(t.w); v[j][7] = bfhi(t.w);
#pragma unroll
        for (int e = 0; e < 8; ++e) s += v[j][e] * v[j][e]; }
    const float inv = 1.0f / sqrtf(wave_sum(s) * (1.f / D) + EPS);
#pragma unroll
    for (int j = 0; j < 4; ++j)
#pragma unroll
        for (int q = 0; q < 2; ++q) { const f32x4 gg = ((const f32x4*)g)[2 * lane + 128 * j + q]; f32x4 o;
#pragma unroll
            for (int e = 0; e < 4; ++e) o[e] = (v[j][4 * q + e] * inv) * gg[e];
            ((f32x4*)orow)[2 * lane + 128 * j + q] = o; }
}

#define MFMA32(a, b, c) __builtin_amdgcn_mfma_f32_32x32x16_bf16((a), (b), (c), 0, 0, 0)
__device__ __forceinline__ int crow(int reg, int h) { return (reg & 3) + 8 * (reg >> 2) + 4 * h; }
#define FENCE8(a) asm volatile("" : "+v"((a)[0]), "+v"((a)[1]), "+v"((a)[2]), "+v"((a)[3]), "+v"((a)[4]), "+v"((a)[5]), "+v"((a)[6]), "+v"((a)[7]))
__device__ __forceinline__ void attn_subblock(const LAS unsigned char* Ks, const LAS unsigned char* Vs, const bf16x8 (&bq)[8], bf16x8 (&bqn)[8], const bf16* qn, bool PREFETCH, bf16* orow, int t0, int n, float sink2, int r, int h) {
    constexpr int KRS = 272, VRS = 320;
    const int kt0 = t0 >> 5;
        f32x16 X[5];
        bf16x8 kf[2][8];
        {   const LAS unsigned char* kp = Ks + (32 * kt0 + r) * KRS + 16 * h;
#pragma unroll
            for (int ks = 0; ks < 8; ++ks) kf[0][ks] = *(const LAS bf16x8*)(kp + 32 * ks); }
#pragma unroll
        for (int kk = 0; kk < 5; ++kk) {
            if (kk < 4) { const LAS unsigned char* kp = Ks + (32 * (kt0 + kk + 1) + r) * KRS + 16 * h;
#pragma unroll
                for (int ks = 0; ks < 8; ++ks) kf[(kk + 1) & 1][ks] = *(const LAS bf16x8*)(kp + 32 * ks); }
            FENCE8(kf[kk & 1]);
#pragma unroll
            for (int i = 0; i < 16; ++i) X[kk][i] = 0.f;
#pragma unroll
            for (int ks = 0; ks < 8; ++ks) X[kk] = MFMA32(kf[kk & 1][ks], bq[ks], X[kk]);
        }
        if (PREFETCH) {
#pragma unroll
            for (int ks = 0; ks < 8; ++ks) bqn[ks] = *(const bf16x8*)(qn + 16 * ks); }
        const int qi = t0 + r; float mraw = -__builtin_inff();
#pragma unroll
        for (int kk = 0; kk < 5; ++kk) {
            const bool tile_ok = (n > 0) || (kt0 + kk >= 4);
#pragma unroll
            for (int i = 0; i < 16; ++i) { const int kw = 32 * (kt0 + kk) + crow(i, h);
                bool valid = tile_ok;
                if (kk == 0) valid = valid && (kw > qi);
                if (kk == 4) valid = valid && (kw <= qi + 128);
                const float s = valid ? X[kk][i] : -__builtin_inff(); X[kk][i] = s; mraw = fmaxf(mraw, s); }
        }
        mraw = fmaxf(mraw, __shfl_xor(mraw, 32));
        const float mx = fmaxf(sink2, mraw * SC2);
        float sum = 0.f;
        f32x16 O[4];
#pragma unroll
        for (int dt = 0; dt < 4; ++dt)
#pragma unroll
            for (int i = 0; i < 16; ++i) O[dt][i] = 0.f;
#pragma unroll
        for (int kk = 0; kk < 5; ++kk) {
            v4u av[8];
            const LAS unsigned char* vp = Vs + (32 * (kt0 + kk) + 4 * h + ((r >> 2) & 3)) * VRS + (16 * ((r >> 4) & 1) + 4 * (r & 3)) * 2;
#pragma unroll
            for (int s2 = 0; s2 < 2; ++s2)
#pragma unroll
                for (int dt = 0; dt < 4; ++dt) {
                    const v2u lo = __builtin_bit_cast(v2u, __builtin_amdgcn_ds_read_tr16_b64_v4i16((LAS v4i16_t*)(vp + 16 * s2 * VRS + 64 * dt)));
                    const v2u hi = __builtin_bit_cast(v2u, __builtin_amdgcn_ds_read_tr16_b64_v4i16((LAS v4i16_t*)(vp + 16 * s2 * VRS + 64 * dt + 8 * VRS)));
                    v4u a; a.x = lo.x; a.y = lo.y; a.z = hi.x; a.w = hi.y; av[4 * s2 + dt] = a; }
#pragma unroll
            for (int i = 0; i < 16; ++i) { const float p = __builtin_amdgcn_exp2f(__builtin_fmaf(X[kk][i], SC2, -mx)); X[kk][i] = p; sum += p; }
            FENCE8(av);
#pragma unroll
            for (int s2 = 0; s2 < 2; ++s2) {
                v4u pw; pw.x = pk2(X[kk][8 * s2 + 0], X[kk][8 * s2 + 1]); pw.y = pk2(X[kk][8 * s2 + 2], X[kk][8 * s2 + 3]);
                pw.z = pk2(X[kk][8 * s2 + 4], X[kk][8 * s2 + 5]); pw.w = pk2(X[kk][8 * s2 + 6], X[kk][8 * s2 + 7]);
                const bf16x8 pb = __builtin_bit_cast(bf16x8, pw);
#pragma unroll
                for (int dt = 0; dt < 4; ++dt) O[dt] = MFMA32(__builtin_bit_cast(bf16x8, av[4 * s2 + dt]), pb, O[dt]);
            }
        }
        sum += __shfl_xor(sum, 32);
        const float inv = 1.0f / (sum + __builtin_amdgcn_exp2f(sink2 - mx));
#pragma unroll
        for (int dt = 0; dt < 4; ++dt)
#pragma unroll
            for (int g4 = 0; g4 < 4; ++g4) { v2u w; w.x = pk2(O[dt][4 * g4] * inv, O[dt][4 * g4 + 1] * inv); w.y = pk2(O[dt][4 * g4 + 2] * inv, O[dt][4 * g4 + 3] * inv);
                *(v2u*)(orow + 32 * dt + 8 * g4 + 4 * h) = w; }
}
__device__ __forceinline__ void attn_unit(LAS unsigned char* lds, int b, int n, int hkv, const bf16* QA, bf16* OA, const bf16* Kb, const bf16* Vt, const float* sinks_l, int tid, int wave, int lane) {
    constexpr int KRS = 272, VRS = 320;
    LAS unsigned char* Ks = lds; LAS unsigned char* Vs = lds + 256 * KRS;
    const int blk0 = b * SEQ + n * 128, prev0 = n > 0 ? blk0 - 128 : blk0;
    const int g = wave >> 1, rh = wave & 1, head = hkv * 4 + g, r = lane & 31, h = lane >> 5;
    bf16x8 bqA[8], bqB[8];
    {   const bf16* q0 = QA + (size_t)(blk0 + 64 * rh + r) * D + head * 128 + 8 * h;
#pragma unroll
        for (int ks = 0; ks < 8; ++ks) bqA[ks] = *(const bf16x8*)(q0 + 16 * ks); }
    {
        v4u kv[8], vv[8];
#pragma unroll
        for (int i = 0; i < 8; ++i) { const int row = (tid >> 4) + 32 * i, ch = tid & 15; const int tok = row < 128 ? prev0 + row : blk0 + row - 128;
            kv[i] = *(const v4u*)(Kb + (size_t)tok * 512 + hkv * 128 + ch * 8); }
#pragma unroll
        for (int i = 0; i < 8; ++i) { const int row = (tid >> 4) + 32 * i, ch = tid & 15; const int tok = row < 128 ? prev0 + row : blk0 + row - 128;
            vv[i] = *(const v4u*)(Vt + (size_t)tok * 512 + hkv * 128 + ch * 8); }
        FENCE8(kv);
#pragma unroll
        for (int i = 0; i < 8; ++i) { const int row = (tid >> 4) + 32 * i, ch = tid & 15; *(LAS v4u*)(Ks + row * KRS + ch * 16) = kv[i]; }
        FENCE8(vv);
#pragma unroll
        for (int i = 0; i < 8; ++i) { const int row = (tid >> 4) + 32 * i, ch = tid & 15; *(LAS v4u*)(Vs + row * VRS + ch * 16) = vv[i]; }
    }
    const float sink2 = sinks_l[head] * LOG2E;
    FENCE8(bqA);
    __syncthreads();
#pragma unroll 1
    for (int sb = 0; sb < 2; ++sb) {
        const size_t rowoff = (size_t)(blk0 + 64 * rh + 32 * sb + r) * D + head * 128;
        attn_subblock(Ks, Vs, bqA, bqB, QA + rowoff + (size_t)32 * D + 8 * h, sb == 0, OA + rowoff, 64 * rh + 32 * sb, n, sink2, r, h);
        if (sb == 0) {
#pragma unroll
            for (int ks = 0; ks < 8; ++ks) bqA[ks] = bqB[ks]; }
    }
    __syncthreads();
}

__device__ __forceinline__ void lru_load_rows(v4u (&dst)[11], const bf16* U, int b, int s, int tq, int chan0) {
#pragma unroll
    for (int i = 0; i < 11; ++i) { const int pos = 256 * s + 8 * tq - 3 + i; v4u v; v.x = 0u; v.y = 0u; v.z = 0u; v.w = 0u;
        if (pos >= 0 && pos < SEQ) v = *(const v4u*)(U + (size_t)(b * SEQ + pos) * D + chan0);
        dst[i] = v; }
}
__device__ __forceinline__ void lru_seq(LAS unsigned char* lds, int b, int hd, int ct, const bf16* U, const bf16* LG, bf16* YL,
                                        const float* conv_w, const float* conv_b, const float* ba, const float* bx, const float* lam, const bf16* WAt, const bf16* WXt,
                                        int tid, int wave, int lane) {
    constexpr int RS = 272, TS = 80;
    LAS unsigned char* UCs = lds; LAS unsigned char* WAs = lds + 256 * RS; LAS unsigned char* WXs = WAs + 32 * RS;
    LAS float* EX = (LAS float*)(WXs + 32 * RS);
    LAS float* CW = EX + 512;
    LAS unsigned char* GL0 = (LAS unsigned char*)(CW + 640);
    LAS unsigned char* YTs = GL0 + 2 * 256 * TS;
    { const int row = tid >> 4, chk = tid & 15;
        *(LAS v4u*)(WAs + row * RS + chk * 16) = *(const v4u*)(WAt + (size_t)(hd * 128 + 32 * ct + row) * 128 + chk * 8);
        *(LAS v4u*)(WXs + row * RS + chk * 16) = *(const v4u*)(WXt + (size_t)(hd * 128 + 32 * ct + row) * 128 + chk * 8); }
    for (int i = tid; i < 640; i += NWAVES * 64) { const int k = i >> 7, c = i & 127; CW[i] = (k < 4) ? conv_w[k * D + hd * 128 + c] : conv_b[hd * 128 + c]; }
    const int c8 = tid & 15, tq = tid >> 4, chan0 = hd * 128 + c8 * 8;
    const int r = lane & 31, h = lane >> 5, ch = hd * 128 + 32 * ct + r;
    const float bav = ba[ch], bxv = bx[ch];
    const float sp8 = 8.0f * LOG2E * log1pf(expf(-lam[ch]));
    const int grow = tid >> 2, gq = tid & 3;
    float carry = 0.f;
    v4u raw[11], glr[2];
    lru_load_rows(raw, U, b, 0, tq, chan0);
#pragma unroll
    for (int q = 0; q < 2; ++q) glr[q] = *(const v4u*)(LG + (size_t)(b * SEQ + grow + 128 * q) * D + hd * 128 + 32 * ct + gq * 8);
    __syncthreads();
#pragma unroll 1
    for (int s = 0; s < 16; ++s) {
        {
            f32x4 cwv[5][2];
#pragma unroll
            for (int k = 0; k < 5; ++k) { cwv[k][0] = *(const LAS f32x4*)(CW + k * 128 + c8 * 8); cwv[k][1] = *(const LAS f32x4*)(CW + k * 128 + c8 * 8 + 4); }
#pragma unroll
            for (int j = 0; j < 8; ++j) {
                f32x4 o0 = cwv[4][0], o1 = cwv[4][1];
#pragma unroll
                for (int k = 0; k < 4; ++k) { const v4u v = raw[j + k];
                    o0[0] += cwv[k][0][0] * bflo(v.x); o0[1] += cwv[k][0][1] * bfhi(v.x); o0[2] += cwv[k][0][2] * bflo(v.y); o0[3] += cwv[k][0][3] * bfhi(v.y);
                    o1[0] += cwv[k][1][0] * bflo(v.z); o1[1] += cwv[k][1][1] * bfhi(v.z); o1[2] += cwv[k][1][2] * bflo(v.w); o1[3] += cwv[k][1][3] * bfhi(v.w); }
                v4u w; w.x = pk2(o0[0], o0[1]); w.y = pk2(o0[2], o0[3]); w.z = pk2(o1[0], o1[1]); w.w = pk2(o1[2], o1[3]);
                *(LAS v4u*)(UCs + (8 * tq + j) * RS + c8 * 16) = w;
            }
#pragma unroll
            for (int q = 0; q < 2; ++q) *(LAS v4u*)(GL0 + (s & 1) * 256 * TS + (grow + 128 * q) * TS + gq * 16) = glr[q];
        }
        if (s < 15) {
            const bf16* nb = U + (size_t)(b * SEQ + 256 * (s + 1) + 8 * tq - 3) * D + chan0;
#pragma unroll
            for (int i = 0; i < 11; ++i) raw[i] = *(const v4u*)(nb + (size_t)i * D);
#pragma unroll
            for (int q = 0; q < 2; ++q) glr[q] = *(const v4u*)(LG + (size_t)(b * SEQ + 256 * (s + 1) + grow + 128 * q) * D + hd * 128 + 32 * ct + gq * 8);
        }
        __syncthreads();
        if (s > 0) {
#pragma unroll
            for (int q = 0; q < 2; ++q) *(v4u*)(YL + (size_t)(b * SEQ + 256 * (s - 1) + grow + 128 * q) * D + hd * 128 + 32 * ct + gq * 8) = *(const LAS v4u*)(YTs + (grow + 128 * q) * TS + gq * 16);
        }
        f32x16 ga, gx;
#pragma unroll
        for (int i = 0; i < 16; ++i) { ga[i] = 0.f; gx[i] = 0.f; }
        {   const LAS unsigned char* ap = UCs + (32 * wave + r) * RS + 16 * h;
            const LAS unsigned char* wap = WAs + r * RS + 16 * h;
            const LAS unsigned char* wxp = WXs + r * RS + 16 * h;
#pragma unroll
            for (int ks = 0; ks < 8; ++ks) { const bf16x8 a = *(const LAS bf16x8*)(ap + 32 * ks);
                ga = MFMA32(a, *(const LAS bf16x8*)(wap + 32 * ks), ga); gx = MFMA32(a, *(const LAS bf16x8*)(wxp + 32 * ks), gx); } }
        float P[16], Hl[16];
#pragma unroll
        for (int i = 0; i < 16; i += 2) {
            typedef float f2 __attribute__((ext_vector_type(2)));
            f2 ucv; ucv.x = bf2f(*(const LAS bf16*)(UCs + (32 * wave + crow(i, h)) * RS + (32 * ct + r) * 2)); ucv.y = bf2f(*(const LAS bf16*)(UCs + (32 * wave + crow(i + 1, h)) * RS + (32 * ct + r) * 2));
            f2 za; za.x = ga[i]; za.y = ga[i + 1]; f2 zx; zx.x = gx[i]; zx.y = gx[i + 1];
            za = (za + bav) * (-LOG2E); zx = (zx + bxv) * (-LOG2E);
            f2 ea; ea.x = __builtin_amdgcn_exp2f(za.x); ea.y = __builtin_amdgcn_exp2f(za.y);
            f2 ex; ex.x = __builtin_amdgcn_exp2f(zx.x); ex.y = __builtin_amdgcn_exp2f(zx.y);
            ea = ea + 1.0f; ex = ex + 1.0f;
            f2 rg; rg.x = __builtin_amdgcn_rcpf(ea.x); rg.y = __builtin_amdgcn_rcpf(ea.y);
            f2 ig; ig.x = __builtin_amdgcn_rcpf(ex.x); ig.y = __builtin_amdgcn_rcpf(ex.y);
            const f2 la = rg * (-sp8);
            f2 a; a.x = __builtin_amdgcn_exp2f(la.x); a.y = __builtin_amdgcn_exp2f(la.y);
            const f2 om = 1.0f - a * a;
            f2 beta; beta.x = __builtin_amdgcn_sqrtf(om.x); beta.y = __builtin_amdgcn_sqrtf(om.y);
            const f2 inp = beta * ig * ucv;
            P[i] = a.x; P[i + 1] = a.y; Hl[i] = inp.x; Hl[i + 1] = inp.y;
        }
        float Ar[4], Hr[4], ArP[4], HrP[4], cin0[4], apre[4];
#pragma unroll
        for (int g = 0; g < 4; ++g) {
#pragma unroll
            for (int e = 1; e < 4; ++e) { Hl[4 * g + e] = P[4 * g + e] * Hl[4 * g + e - 1] + Hl[4 * g + e]; P[4 * g + e] = P[4 * g + e] * P[4 * g + e - 1]; }
            Ar[g] = P[4 * g + 3]; Hr[g] = Hl[4 * g + 3];
            ArP[g] = __shfl_xor(Ar[g], 32); HrP[g] = __shfl_xor(Hr[g], 32);
        }
        float cur = 0.f, curA = 1.f;
#pragma unroll
        for (int g = 0; g < 4; ++g) {
            const float A0 = h ? ArP[g] : Ar[g], H0 = h ? HrP[g] : Hr[g], A1 = h ? Ar[g] : ArP[g], H1 = h ? Hr[g] : HrP[g];
            const float c0 = cur, p0 = curA; cur = A0 * cur + H0; curA *= A0;
            const float c1 = cur, p1 = curA; cur = A1 * cur + H1; curA *= A1;
            cin0[g] = h ? c1 : c0; apre[g] = h ? p1 : p0;
        }
        if (h == 0) { EX[wave * 64 + r] = curA; EX[wave * 64 + 32 + r] = cur; }
        __syncthreads();
        float cin = carry, mycin = 0.f;
#pragma unroll
        for (int w = 0; w < 8; ++w) { const float a = EX[w * 64 + r], hh = EX[w * 64 + 32 + r]; if (w == wave) mycin = cin; cin = a * cin + hh; }
        carry = cin;
#pragma unroll
        for (int g = 0; g < 4; ++g) {
            const float cg_ = cin0[g] + apre[g] * mycin;
#pragma unroll
            for (int e = 0; e < 4; ++e) {
                const int trow = 32 * wave + 8 * g + 4 * h + e;
                const float hv = Hl[4 * g + e] + P[4 * g + e] * cg_;
                const float gate = bf2f(*(const LAS bf16*)(GL0 + (s & 1) * 256 * TS + trow * TS + r * 2));
                *(LAS bf16*)(YTs + trow * TS + r * 2) = (bf16)(pk2(hv * gate, 0.f) & 0xffffu);
            }
        }
    }
    __syncthreads();
#pragma unroll
    for (int q = 0; q < 2; ++q) *(v4u*)(YL + (size_t)(b * SEQ + 256 * 15 + grow + 128 * q) * D + hd * 128 + 32 * ct + gq * 8) = *(const LAS v4u*)(YTs + (grow + 128 * q) * TS + gq * 16);
    __syncthreads();
}

#define XB_TMO      128
#define XB_XCNT(j)  (256  + 64 * (j))
#define XB_XSUB(j)  (1280 + 64 * (j))
#define XB_XGEN(j)  (2304 + 64 * (j))
#define XB_TOP      3328
#define XB_TOPGEN   3392
#define XCD_BAR_WORDS 3456
#define XB_SPIN_CAP (1u << 21)
__device__ __forceinline__ unsigned xb_ld(unsigned* p)              { return __hip_atomic_load(p, __ATOMIC_RELAXED, __HIP_MEMORY_SCOPE_AGENT); }
__device__ __forceinline__ unsigned xb_add(unsigned* p, unsigned v) { return __hip_atomic_fetch_add(p, v, __ATOMIC_RELAXED, __HIP_MEMORY_SCOPE_AGENT); }
__device__ __forceinline__ unsigned xb_xcc_id() { return (unsigned)__builtin_amdgcn_s_getreg((3 << 11) | 20) & 0xFu; }
#define XB_SPIN(cond, bar) do { unsigned _sp = 0; while (cond) { __builtin_amdgcn_s_sleep(1); \
    if ((++_sp & 255u) == 0u) { if (xb_ld(&(bar)[XB_TMO])) break; if (_sp > XB_SPIN_CAP) { atomicAdd(&(bar)[XB_TMO], 1u); break; } } } } while (0)
struct XcdBarrier { unsigned* bar; unsigned x; volatile LAS unsigned* st; };
__device__ __forceinline__ XcdBarrier xcd_barrier_post(unsigned* bar, volatile LAS unsigned* st) {
    XcdBarrier b; b.bar = bar; b.x = xb_xcc_id(); b.st = st;
    if (threadIdx.x == 0) st[2] = xb_add(&bar[XB_XCNT(b.x)], 1u);
    return b;
}
__device__ __forceinline__ void xcd_barrier_complete(unsigned* bar, unsigned x, unsigned& nloc, unsigned& nx) {
    const unsigned G = gridDim.x * gridDim.y * gridDim.z;
    unsigned sum, cnt, mine, sp = 0u;
    for (;;) {
        sum = 0u; cnt = 0u; mine = 0u;
#pragma unroll
        for (unsigned j = 0; j < 16; ++j) { const unsigned c = xb_ld(&bar[XB_XCNT(j)]); sum += c; cnt += (c > 0u) ? 1u : 0u; mine = (j == x) ? c : mine; }
        if (sum == G) break;
        __builtin_amdgcn_s_sleep(1);
        if ((++sp & 255u) == 0u) { if (xb_ld(&bar[XB_TMO])) break; if (sp > XB_SPIN_CAP) { atomicAdd(&bar[XB_TMO], 1u); break; } }
    }
    nloc = mine > 0u ? mine : 1u; nx = cnt > 0u ? cnt : 1u;
}
__device__ __forceinline__ void xcd_barrier(const XcdBarrier& b) {
    asm volatile("s_waitcnt vmcnt(0)" ::: "memory");
    __syncthreads();
    if (threadIdx.x == 0) {
        unsigned* bar = b.bar;
        __builtin_amdgcn_s_waitcnt(0);
        unsigned nloc = b.st[0], nx = b.st[1];
        if (nloc == 0u) { xcd_barrier_complete(bar, b.x, nloc, nx); b.st[0] = nloc; b.st[1] = nx; }
        const unsigned old = xb_add(&bar[XB_XSUB(b.x)], 1u);
        const unsigned gen = old / nloc;
        if (old + 1u == (gen + 1u) * nloc) {
            __builtin_amdgcn_fence(__ATOMIC_RELEASE, "agent");
            asm volatile("s_waitcnt vmcnt(0)" ::: "memory");
            const unsigned og = xb_add(&bar[XB_TOP], 1u);
            const unsigned tg = og / nx;
            if (og + 1u == (tg + 1u) * nx) xb_add(&bar[XB_TOPGEN], 1u);
            else XB_SPIN(xb_ld(&bar[XB_TOPGEN]) == tg, bar);
            __builtin_amdgcn_fence(__ATOMIC_ACQUIRE, "agent");
            xb_add(&bar[XB_XGEN(b.x)], 1u);
            asm volatile("s_waitcnt vmcnt(0)" ::: "memory");
        } else {
            XB_SPIN(xb_ld(&bar[XB_XGEN(b.x)]) == gen, bar);
            __builtin_amdgcn_fence(__ATOMIC_ACQUIRE, "agent");
            asm volatile("s_waitcnt vmcnt(0)" ::: "memory");
        }
    }
    __syncthreads();
}

struct Args { const float* in[22]; float* out; unsigned char* ws; };
enum { I_X = 0, I_C, I_ADAW, I_ADAB, I_N1G, I_WIN, I_BIN, I_CONVW, I_CONVB, I_WA, I_BA, I_WX, I_BX, I_LAM, I_SINKS, I_WLO, I_WAO, I_WO, I_N2G, I_WFI, I_WFO, I_FG };

__global__ void __launch_bounds__(NWAVES * 64, 2) mk_fwd(Args args) {
    extern __shared__ __attribute__((aligned(16))) unsigned char lds_raw[];
    cg::grid_group grid = cg::this_grid();
    LAS unsigned char* lds = (LAS unsigned char*)lds_raw;
#define GSYNC() xcd_barrier(xbar)
#define FRESH_TID() int tid_f = threadIdx.x; asm volatile("" : "+v"(tid_f)); const int tid = tid_f, lane = tid_f & 63; (void)tid; (void)lane
    const int wave = __builtin_amdgcn_readfirstlane((int)threadIdx.x >> 6);
    const int G = gridDim.x, bx = blockIdx.x;
    const int vcu = (G % 8 == 0) ? (bx % 8) * (G / 8) + bx / 8 : bx;
    const int gw = vcu * NWAVES + wave, NGW = G * NWAVES;
    unsigned char* ws = args.ws;
    volatile LAS unsigned* xst = (volatile LAS unsigned*)(lds + LDS_BYTES - 64);
    if (threadIdx.x == 0) { xst[0] = 0u; xst[1] = 0u; xst[2] = 0u; xst[3] = 0u; }
    __syncthreads();
    const XcdBarrier xbar = xcd_barrier_post((unsigned*)(ws + WS_BAR), xst);
    float* MODP = (float*)(ws + WS_MODP); float* MOD = (float*)(ws + WS_MOD);
    bf16* Hb = (bf16*)(ws + WS_H); bf16* Ub = (bf16*)(ws + WS_U); bf16* LGb = (bf16*)(ws + WS_LG); bf16* Qb = (bf16*)(ws + WS_Q);
    bf16* Kbuf = (bf16*)(ws + WS_K); bf16* Vtb = (bf16*)(ws + WS_VT); bf16* MGb = (bf16*)(ws + WS_MG); bf16* HIDb = (bf16*)(ws + WS_HID);
    float* xout = args.out; bf16* XB = (bf16*)(ws + WS_XB);

    {
        FRESH_TID();
        LAS float* scr = (LAS float*)(lds + wave * 16384);
        for (int it = gw; it < 2 * 48 * 16; it += NGW) {
            const int ks = it & 15, nb = (it >> 4) % 48, l = it / (16 * 48);
            const float* cp = args.in[I_C];
            float sv[4][2];
#pragma unroll
            for (int b = 0; b < 4; ++b)
#pragma unroll
                for (int q = 0; q < 2; ++q) { const float c = cp[b * D + ks * 128 + q * 64 + lane]; sv[b][q] = c * sigmoid_f(c); }
            const float* wp = args.in[I_ADAW] + ((size_t)l * D + ks * 128) * (NMOD * D) + nb * 256 + lane * 4;
            f32x4 acc[4];
#pragma unroll
            for (int b = 0; b < 4; ++b) acc[b] = (f32x4){0.f, 0.f, 0.f, 0.f};
#pragma unroll
            for (int q = 0; q < 2; ++q)
#pragma unroll 8
                for (int kk = 0; kk < 64; ++kk) {
                    const f32x4 w = *(const f32x4*)(wp + (size_t)(q * 64 + kk) * (NMOD * D));
#pragma unroll
                    for (int b = 0; b < 4; ++b) acc[b] += w * __shfl(sv[b][q], kk);
                }
#pragma unroll
            for (int b = 0; b < 4; ++b) *(f32x4*)(MODP + ((size_t)((l * 16 + ks) * 4 + b)) * (NMOD * D) + nb * 256 + lane * 4) = acc[b];
        }
        constexpr int I_IN = 32 * (CIN / 32), I_SQ = 32 * (D / 32), I_FO = (FFN / 64) * (D / 32), I_LR = 16 * 2 * 4;
        constexpr int PER_L = 2 * I_IN + 3 * I_SQ + I_FO + 2 * I_LR;
        for (int it = gw; it < 2 * PER_L; it += NGW) {
            const int l = it / PER_L; int rr = it % PER_L;
            unsigned char* wl = ws + WS_W + (size_t)l * W_LAYER;
            if (rr < I_IN) { transpose_mat(args.in[I_WIN] + (size_t)l * D * CIN, D, CIN, (bf16*)(wl + WO_IN), rr, scr, lane, 2); continue; } rr -= I_IN;
            if (rr < I_IN) { transpose_mat(args.in[I_WFI] + (size_t)l * D * CIN, D, CIN, (bf16*)(wl + WO_FI), rr, scr, lane, 1); continue; } rr -= I_IN;
            if (rr < I_SQ) { transpose_mat(args.in[I_WLO] + (size_t)l * D * D, D, D, (bf16*)(wl + WO_LO), rr, scr, lane, 0); continue; } rr -= I_SQ;
            if (rr < I_SQ) { transpose_mat(args.in[I_WAO] + (size_t)l * D * D, D, D, (bf16*)(wl + WO_AO), rr, scr, lane, 0); continue; } rr -= I_SQ;
            if (rr < I_SQ) { transpose_mat(args.in[I_WO] + (size_t)l * D * D, D, D, (bf16*)(wl + WO_O), rr, scr, lane, 0); continue; } rr -= I_SQ;
            if (rr < I_FO) { transpose_mat(args.in[I_WFO] + (size_t)l * FFN * D, FFN, D, (bf16*)(wl + WO_FO), rr, scr, lane, 0); continue; } rr -= I_FO;
            {
                const bool second = rr >= I_LR; if (second) rr -= I_LR;
                const int hd = rr >> 3, sub = rr & 7;
                const float* src = args.in[second ? I_WX : I_WA] + ((size_t)l * 16 + hd) * 128 * 128;
                bf16* dst = (bf16*)(wl + (second ? WO_WX : WO_WA)) + (size_t)hd * 128 * 128;
                transpose_mat(src, 128, 128, dst, sub, scr, lane, 0);
            }
        }
    }
    GSYNC();
    if (args.ws == nullptr) grid.sync();
    int vb = bx;
    {   if (threadIdx.x == 0) { unsigned* bar = (unsigned*)(ws + WS_BAR); bool ok = (G % 8 == 0);
            for (unsigned j = 0; j < 16; ++j) { const unsigned c = xb_ld(&bar[XB_XCNT(j)]); ok = ok && (c == (j < 8 ? (unsigned)(G / 8) : 0u)); }
            xst[3] = ok ? (xbar.x + 8u * xst[2]) : (unsigned)bx; }
        __syncthreads();
        vb = __builtin_amdgcn_readfirstlane((int)xst[3]); }
    const int vgw = ((G % 8 == 0) ? (vb % 8) * (G / 8) + vb / 8 : vb) * NWAVES + wave;
    { FRESH_TID();
    for (int i = bx * (NWAVES * 64) + tid; i < 2 * 4 * NMOD * D; i += G * NWAVES * 64) {
        const int n = i % (NMOD * D), lb = i / (NMOD * D), l = lb >> 2, b = lb & 3;
        float s = args.in[I_ADAB][l * NMOD * D + n];
#pragma unroll
        for (int ks = 0; ks < 16; ++ks) s += MODP[((size_t)((l * 16 + ks) * 4 + b)) * (NMOD * D) + n];
        MOD[i] = s;
    } }
    GSYNC();

#pragma unroll 1
    for (int l = 0; l < DEPTH; ++l) {
        const float* modl = MOD + (size_t)l * 4 * NMOD * D;
        unsigned char* wl = ws + WS_W + (size_t)l * W_LAYER;
        { FRESH_TID();
        if (l == 0) {
            for (int m = vgw; m < M; m += NGW) { const float* mb = modl + (m >> 12) * (NMOD * D);
                norm_row_bf16(args.in[I_X] + (size_t)m * D, Hb + (size_t)m * D, args.in[I_N1G] + l * D, mb, mb + D, lane); }
        } else {
            for (int m = vgw; m < M; m += 2 * NGW) { const float* mb = modl + (m >> 12) * (NMOD * D);
                if (m + NGW < M) { const float* mb2 = modl + ((m + NGW) >> 12) * (NMOD * D);
                    norm_2rows_bf16in(XB + (size_t)m * D, XB + (size_t)(m + NGW) * D, Hb + (size_t)m * D, Hb + (size_t)(m + NGW) * D, args.in[I_N1G] + l * D, mb, mb + D, mb2, mb2 + D, lane); }
                else norm_row_bf16in(XB + (size_t)m * D, Hb + (size_t)m * D, args.in[I_N1G] + l * D, mb, mb + D, lane); }
        } }
        GSYNC();
        {   pg8::Gemm g{Hb, (const bf16*)(wl + WO_IN), M, CIN, D}; pg8::StaticOrder S; S.init(M, CIN, G, vb);
            EpiIn E{args.in[I_BIN] + (size_t)l * CIN, Ub, LGb, Qb, Kbuf, Vtb, MGb};
            pg8::gemm_phase<EpiIn, pg8::StaticOrder, true, true>(lds, g, S, E); }
        GSYNC();
        {
            FRESH_TID();
            for (int u = vb; u < 4 * 16 * 4; u += G) {
                const int xc = u & 7, rk = u >> 3, ct = rk & 3, bh = xc + 8 * (rk >> 2), hd = bh & 15, b = bh >> 4;
                lru_seq(lds, b, hd, ct, Ub, LGb, Hb, args.in[I_CONVW] + (size_t)l * 4 * D, args.in[I_CONVB] + l * D, args.in[I_BA] + l * D, args.in[I_BX] + l * D,
                        args.in[I_LAM] + l * D, (const bf16*)(wl + WO_WA), (const bf16*)(wl + WO_WX), tid, wave, lane); }
            for (int u = vb; u < 4 * 32 * 4; u += G) { const int hkv = u & 3, n = (u >> 2) & 31, b = u >> 7;
                attn_unit(lds, b, n, hkv, Qb, Qb, Kbuf, Vtb, args.in[I_SINKS] + l * 16, tid, wave, lane); }
        }
        GSYNC();
        {   pg8::Gemm g{Hb, (const bf16*)(wl + WO_LO), M, D, D, Qb, (const bf16*)(wl + WO_AO)}; pg8::StaticOrder S; S.init(M, D, G, vb);
            EpiMerge E{MGb, Ub};
            pg8::gemm_phase<EpiMerge, pg8::StaticOrder, true, true>(lds, g, S, E); }
        GSYNC();
        {   pg8::Gemm g{Ub, (const bf16*)(wl + WO_O), M, D, D}; pg8::StaticOrder S; S.init(M, D, G, vb);
            EpiRes E{(l == 0) ? (const void*)args.in[I_X] : (const void*)XB, XB, modl + 2 * D, (l == 0) ? 1 : 0};
            pg8::gemm_phase<EpiRes, pg8::StaticOrder, true, true>(lds, g, S, E); }
        GSYNC();
        { FRESH_TID();
        for (int m = vgw; m < M; m += 2 * NGW) {
            const float* mb = modl + (m >> 12) * (NMOD * D);
            if (m + NGW < M) { const float* mb2 = modl + ((m + NGW) >> 12) * (NMOD * D);
                norm_2rows_bf16in(XB + (size_t)m * D, XB + (size_t)(m + NGW) * D, Hb + (size_t)m * D, Hb + (size_t)(m + NGW) * D, args.in[I_N2G] + l * D, mb + 3 * D, mb + 4 * D, mb2 + 3 * D, mb2 + 4 * D, lane); }
            else norm_row_bf16in(XB + (size_t)m * D, Hb + (size_t)m * D, args.in[I_N2G] + l * D, mb + 3 * D, mb + 4 * D, lane); } }
        GSYNC();
        {   pg8::Gemm g{Hb, (const bf16*)(wl + WO_FI), M, CIN, D}; pg8::StaticOrder S; S.init(M, CIN, G, vb);
            EpiSwiglu E{HIDb};
            pg8::gemm_phase<EpiSwiglu, pg8::StaticOrder, true, true>(lds, g, S, E); }
        GSYNC();
        {   pg8::Gemm g{HIDb, (const bf16*)(wl + WO_FO), M, D, FFN}; pg8::StaticOrder S; S.init(M, D, G, vb);
            EpiRes E{(const void*)XB, XB, modl + 5 * D, 0};
            pg8::gemm_phase<EpiRes, pg8::StaticOrder, true, true>(lds, g, S, E); }
        GSYNC();
    }
    FRESH_TID();
    for (int m = vgw; m < M; m += NGW) final_norm_row(XB + (size_t)m * D, xout + (size_t)m * D, args.in[I_FG], lane);
}

extern "C" void kernel_launch(void* const* d_in, const int* in_sizes, int n_in, void* d_out, int out_size, void* d_ws, size_t ws_size, hipStream_t stream) {
    static int grid = 0;
    if (grid == 0) {
        if (n_in != 22 || in_sizes[0] != M * D || out_size != M * D || ws_size < WS_END) { fprintf(stderr, "kernel_launch: unexpected shapes (n_in %d, in0 %d, out %d, ws %zu); nothing launched\n", n_in, n_in > 0 ? in_sizes[0] : -1, out_size, ws_size); grid = -1; return; }
        int dev = 0, cus = 0, per_cu = 0;
        if (hipGetDevice(&dev) != hipSuccess || hipDeviceGetAttribute(&cus, hipDeviceAttributeMultiprocessorCount, dev) != hipSuccess) { grid = -1; return; }
        if (hipFuncSetAttribute((const void*)mk_fwd, hipFuncAttributeMaxDynamicSharedMemorySize, LDS_BYTES) != hipSuccess) { fprintf(stderr, "kernel_launch: hipFuncSetAttribute failed\n"); grid = -1; return; }
        if (hipOccupancyMaxActiveBlocksPerMultiprocessor(&per_cu, (const void*)mk_fwd, NWAVES * 64, LDS_BYTES) != hipSuccess || per_cu < 1) { fprintf(stderr, "kernel_launch: occupancy query gave %d\n", per_cu); per_cu = 1; }
        (void)hipGetLastError();
        grid = cus * per_cu;
    }
    if (grid < 0) return;
    Args a{};
    for (int i = 0; i < 22; ++i) a.in[i] = (const float*)d_in[i];
    a.out = (float*)d_out; a.ws = (unsigned char*)d_ws;
    if (hipMemsetAsync((char*)d_ws + WS_BAR, 0, BAR_ZERO_BYTES, stream) != hipSuccess) { fprintf(stderr, "kernel_launch: memset failed\n"); return; }
    void* kargs[] = {&a};
    hipError_t e = hipLaunchCooperativeKernel((const void*)mk_fwd, dim3(grid), dim3(NWAVES * 64), kargs, LDS_BYTES, stream);
    if (e != hipSuccess) fprintf(stderr, "kernel_launch: cooperative launch failed: %s (grid %d)\n", hipGetErrorString(e), grid);
}
```
